# Optimizing an MI355X kernel written in HIP

```python
import math
import jax
import jax.numpy as jnp
from jax import lax
import numpy as np

D_MODEL = 2048
BATCH = 8
SEQ = 2048
DEPTH = 2

EPS = 1e-6
D_FF = 5632
HG_HEADS = 4
HG_DK = 128
HG_DV = 128
HG_WIDTH = HG_HEADS * HG_DK
HG_CHUNK = 16
SSM_GROUP = 16
SSM_WIDTH = 512
SSM_GROUPS = SSM_WIDTH // SSM_GROUP
SSM_STATE = 64
NSA_HEADS = 16
NSA_KV_HEADS = 4
NSA_HPG = NSA_HEADS // NSA_KV_HEADS
NSA_DH = 64
NSA_WIDTH = NSA_HEADS * NSA_DH
NSA_KV_WIDTH = NSA_KV_HEADS * NSA_DH
CMP_LEN = 32
CMP_STRIDE = 16
SEL_LEN = 64
SEL_TOPN = 16
SEL_QCHUNK = 16
WIN = 512
WIN_QBLOCK = 128
FORCE_SCORE = 1e4
NEG = -1e30
REL_BUCKETS = 32
REL_MAX_DIST = 128
IN_SPLITS = (HG_WIDTH, HG_WIDTH, HG_WIDTH, HG_WIDTH, SSM_WIDTH, NSA_WIDTH,
             NSA_KV_WIDTH, NSA_KV_WIDTH, NSA_KV_WIDTH, NSA_KV_WIDTH, NSA_KV_WIDTH, NSA_KV_WIDTH,
             3 * NSA_HEADS, D_MODEL, D_MODEL, D_MODEL)
IN_WIDTH = sum(IN_SPLITS)

kernel_name = 'hybrid_gated_hgrn2_s5_nsa_block'


def rms_norm(x, gain):
    xf = x.astype(jnp.float32)
    y = xf * lax.rsqrt(jnp.mean(xf * xf, axis=-1, keepdims=True) + EPS)
    return (y * gain.astype(jnp.float32)).astype(x.dtype)


def head_rms(x, gain):
    return x * lax.rsqrt(jnp.mean(x * x, axis=-1, keepdims=True) + EPS) * gain.astype(jnp.float32)


def modulate(xn, shift, scale):
    return xn * (1.0 + scale) + shift


def swiglu(u, wi, wo):
    a = u @ wi
    return (jax.nn.silu(a[..., :D_FF]) * a[..., D_FF:]) @ wo


def split_cols(z, sizes):
    out, off = [], 0
    for s in sizes:
        out.append(z[..., off:off + s])
        off += s
    return out


def masked_softmax(logits, mask):
    p = jax.nn.softmax(jnp.where(mask, logits, NEG), axis=-1)
    return p * mask


def t5_bucket(dist):
    n = jnp.maximum(dist, 0)
    max_exact = REL_BUCKETS // 2
    nf = jnp.maximum(n, 1).astype(jnp.float32)
    large = max_exact + (jnp.log(nf / max_exact) / math.log(REL_MAX_DIST / max_exact)
                         * (REL_BUCKETS - max_exact)).astype(jnp.int32)
    large = jnp.minimum(large, REL_BUCKETS - 1)
    return jnp.where(n < max_exact, n, large)


def hgrn2(q, f_logit, i, g, lb, onorm):
    f32 = jnp.float32
    B_, S_, _ = q.shape
    H, DK, DV, C = HG_HEADS, HG_DK, HG_DV, HG_CHUNK
    nC = S_ // C
    q = jax.nn.silu(q.astype(f32))
    lb = lb.astype(f32)
    log_f = jnp.logaddexp(jnp.log(lb), jnp.log1p(-lb) + jax.nn.log_sigmoid(f_logit.astype(f32)))
    k = -jnp.expm1(log_f)

    def chunks(z, d):
        return z.reshape(B_, nC, C, H, d).transpose(1, 0, 3, 2, 4)

    qc, kc, ic = chunks(q, DK), chunks(k, DK), chunks(i.astype(f32), DV)
    bc = jnp.cumsum(chunks(log_f, DK), axis=-2)
    causal = jnp.tril(jnp.ones((C, C), dtype=bool))[:, :, None]

    def step(state, inp):
        qx, kx, ix, bx = inp
        dec = jnp.exp(jnp.where(causal, bx[..., :, None, :] - bx[..., None, :, :], -jnp.inf))
        scores = jnp.einsum('bhtk,bhsk,bhtsk->bhts', qx, kx, dec)
        o = scores @ ix + jnp.einsum('bhtk,bhkv->bhtv', qx * jnp.exp(bx), state)
        b_end = bx[..., -1, :]
        state = state * jnp.exp(b_end)[..., None] + jnp.einsum(
            'bhsk,bhsv->bhkv', kx * jnp.exp(b_end[..., None, :] - bx), ix)
        return state, o

    s0 = jnp.zeros((B_, H, DK, DV), f32)
    _, o = lax.scan(step, s0, (qc, kc, ic, bc))
    o = o.transpose(1, 0, 3, 2, 4).reshape(B_, S_, H, DV)
    o = head_rms(o, onorm) * jax.nn.silu(g.astype(f32).reshape(B_, S_, H, DV))
    return o.reshape(B_, S_, H * DV)


def s5_ssm(u, a_re, a_im, log_dt, b_re, b_im, c_re, c_im, d_skip):
    f32 = jnp.float32
    B_, S_, _ = u.shape
    G, P, N = SSM_GROUPS, SSM_GROUP, SSM_STATE
    uf = u.astype(f32).reshape(B_, S_, G, P)
    a_re = jnp.minimum(a_re.astype(f32), -1e-4)
    a_im = a_im.astype(f32)
    dt = jnp.exp(log_dt.astype(f32))[:, None]
    mag = jnp.exp(dt * a_re)
    ab_re, ab_im = mag * jnp.cos(dt * a_im), mag * jnp.sin(dt * a_im)
    den = a_re * a_re + a_im * a_im
    nr = ab_re - 1.0
    z_re = (nr * a_re + ab_im * a_im) / den
    z_im = (ab_im * a_re - nr * a_im) / den
    b_re, b_im = b_re.astype(f32), b_im.astype(f32)
    bb_re = z_re[..., None] * b_re - z_im[..., None] * b_im
    bb_im = z_re[..., None] * b_im + z_im[..., None] * b_re
    bu_re = jnp.einsum('bsgp,gnp->bsgn', uf, bb_re)
    bu_im = jnp.einsum('bsgp,gnp->bsgn', uf, bb_im)
    ar_s = jnp.broadcast_to(ab_re, (1, S_, G, N))
    ai_s = jnp.broadcast_to(ab_im, (1, S_, G, N))

    def combine(e1, e2):
        a1r, a1i, b1r, b1i = e1
        a2r, a2i, b2r, b2i = e2
        return (a2r * a1r - a2i * a1i, a2r * a1i + a2i * a1r,
                a2r * b1r - a2i * b1i + b2r, a2r * b1i + a2i * b1r + b2i)

    _, _, x_re, x_im = lax.associative_scan(combine, (ar_s, ai_s, bu_re, bu_im), axis=1)
    y = (jnp.einsum('bsgn,gpn->bsgp', x_re, c_re.astype(f32))
         - jnp.einsum('bsgn,gpn->bsgp', x_im, c_im.astype(f32))
         + d_skip.astype(f32).reshape(G, P) * uf)
    return y.reshape(B_, S_, G * P)


def nsa_attention(q, k_cmp, v_cmp, k_slc, v_slc, k_win, v_win, gate_logits,
                  q_gain, k_gain, pe_k, pe_v, phi_k, phi_v, rel_table):
    f32 = jnp.float32
    B_, S_, _ = q.shape
    G, HPG, DH = NSA_KV_HEADS, NSA_HPG, NSA_DH
    q = head_rms(q.astype(f32).reshape(B_, S_, G, HPG, DH), q_gain) * (DH ** -0.5)

    def kvr(z):
        return z.astype(f32).reshape(B_, S_, G, DH)

    k_slc, k_win = head_rms(kvr(k_slc), k_gain), head_rms(kvr(k_win), k_gain)
    v_cmp, v_slc, v_win, k_cmp = kvr(v_cmp), kvr(v_slc), kvr(v_win), kvr(k_cmp)
    rel_table = rel_table.astype(f32)
    pos = jnp.arange(S_)

    n_cmp = (S_ - CMP_LEN) // CMP_STRIDE + 1
    starts = jnp.arange(n_cmp) * CMP_STRIDE
    tok = starts[:, None] + jnp.arange(CMP_LEN)[None, :]
    kc = jnp.einsum('bnlgd,lde->bnge', k_cmp[:, tok] + pe_k.astype(f32)[:, None, :], phi_k.astype(f32))
    vc = jnp.einsum('bnlgd,lde->bnge', v_cmp[:, tok] + pe_v.astype(f32)[:, None, :], phi_v.astype(f32))
    kc = head_rms(kc, k_gain)
    dist_c = pos[:, None] - (starts + CMP_LEN - 1)[None, :]
    mask_c = dist_c >= 0
    bias_c = rel_table[t5_bucket(dist_c)].reshape(S_, n_cmp, G, HPG).transpose(0, 2, 3, 1)
    logit_c = jnp.einsum('btghd,bngd->btghn', q, kc) + bias_c
    p_cmp = masked_softmax(logit_c, mask_c[:, None, None, :])
    o_cmp = jnp.einsum('btghn,bngd->btghd', p_cmp, vc)

    n_sel = S_ // SEL_LEN
    n_top = min(SEL_TOPN, n_sel)
    sel_start = jnp.arange(n_sel) * SEL_LEN
    overlap = ((starts[:, None] < sel_start[None, :] + SEL_LEN)
               & (starts[:, None] + CMP_LEN > sel_start[None, :])).astype(f32)
    imp = jnp.einsum('btghn,nj->btgj', p_cmp, overlap)
    blk_t = pos // SEL_LEN
    jb = jnp.arange(n_sel)
    forced = (jb[None] == 0) | (jb[None] == blk_t[:, None]) | (jb[None] == blk_t[:, None] - 1)
    valid = jb[None] <= blk_t[:, None]
    imp = jnp.where(forced[None, :, None, :], FORCE_SCORE, imp)
    imp = jnp.where(valid[None, :, None, :], imp, NEG)
    _, sel_idx = lax.top_k(imp, n_top)

    ksb = k_slc.reshape(B_, n_sel, SEL_LEN, G, DH).transpose(0, 3, 1, 2, 4)
    vsb = v_slc.reshape(B_, n_sel, SEL_LEN, G, DH).transpose(0, 3, 1, 2, 4)
    rel_g = rel_table.reshape(REL_BUCKETS, G, HPG).transpose(1, 0, 2)
    nq = S_ // SEL_QCHUNK
    qs = q.reshape(B_, nq, SEL_QCHUNK, G, HPG, DH).transpose(1, 0, 2, 3, 4, 5)
    idx_s = sel_idx.reshape(B_, nq, SEL_QCHUNK, G, n_top).transpose(1, 0, 2, 3, 4)
    tpos_s = pos.reshape(nq, SEL_QCHUNK)
    bi = jnp.arange(B_)[:, None, None, None]
    gi = jnp.arange(G)[None, None, :, None]

    def sel_chunk(args):
        qx, ix, tp = args
        kx = ksb[bi, gi, ix]
        vx = vsb[bi, gi, ix]
        spos = ix[..., None] * SEL_LEN + jnp.arange(SEL_LEN)
        dist = tp[None, :, None, None, None] - spos
        bias = rel_g[gi[..., None], t5_bucket(dist)].transpose(0, 1, 2, 5, 3, 4)
        logits = jnp.einsum('bqghd,bqgnld->bqghnl', qx, kx) + bias
        m = (dist >= 0)[:, :, :, None]
        sh = logits.shape
        p = masked_softmax(logits.reshape(sh[:4] + (n_top * SEL_LEN,)),
                           jnp.broadcast_to(m, sh).reshape(sh[:4] + (n_top * SEL_LEN,)))
        return jnp.einsum('bqghm,bqgmd->bqghd', p, vx.reshape(sh[0], sh[1], G, n_top * SEL_LEN, DH))

    o_slc = lax.map(sel_chunk, (qs, idx_s, tpos_s))
    o_slc = o_slc.transpose(1, 0, 2, 3, 4, 5).reshape(B_, S_, G, HPG, DH)

    QB = WIN_QBLOCK
    KW = QB + WIN
    n_wb = S_ // QB
    kwp = jnp.pad(k_win, ((0, 0), (WIN, 0), (0, 0), (0, 0)))
    vwp = jnp.pad(v_win, ((0, 0), (WIN, 0), (0, 0), (0, 0)))
    rel = WIN + jnp.arange(QB)[:, None] - jnp.arange(KW)[None, :]
    band = (rel >= 0) & (rel < WIN)
    bias_w = rel_table[t5_bucket(rel)].reshape(QB, KW, G, HPG).transpose(0, 2, 3, 1)
    qw = q.reshape(B_, n_wb, QB, G, HPG, DH).transpose(1, 0, 2, 3, 4, 5)

    def win_block(args):
        ib, qx = args
        start = ib * QB
        kx = lax.dynamic_slice_in_dim(kwp, start, KW, axis=1)
        vx = lax.dynamic_slice_in_dim(vwp, start, KW, axis=1)
        spos = start - WIN + jnp.arange(KW)
        m = band & (spos >= 0)[None, :]
        logits = jnp.einsum('bqghd,bkgd->bqghk', qx, kx) + bias_w
        p = masked_softmax(logits, m[:, None, None, :])
        return jnp.einsum('bqghk,bkgd->bqghd', p, vx)

    o_win = lax.map(win_block, (jnp.arange(n_wb), qw))
    o_win = o_win.transpose(1, 0, 2, 3, 4, 5).reshape(B_, S_, G, HPG, DH)

    gt = jax.nn.sigmoid(gate_logits.astype(f32)).reshape(B_, S_, 3, G, HPG, 1)
    o = gt[:, :, 0] * o_cmp + gt[:, :, 1] * o_slc + gt[:, :, 2] * o_win
    return o.reshape(B_, S_, NSA_WIDTH)


def setup_inputs(seed: int = 0) -> dict:
    key = jax.random.key(seed)
    ks = jax.random.split(key, 32)
    f32 = jnp.float32
    L, D = DEPTH, D_MODEL
    G, P, N = SSM_GROUPS, SSM_GROUP, SSM_STATE

    def nrm(k, shape, s):
        return jax.random.normal(k, shape, f32) * s

    n_idx = jnp.arange(N, dtype=f32)
    return {
        'x': nrm(ks[0], (BATCH, SEQ, D), 1.0),
        'c': nrm(ks[1], (BATCH, D), 1.0),
        'ada_w': nrm(ks[2], (L, D, 9 * D), 0.5 * D ** -0.5),
        'ada_b': nrm(ks[3], (L, 9 * D), 0.01),
        'norm_g': 1.0 + nrm(ks[4], (L, 3, D), 0.01),
        'ffn1_wi': nrm(ks[5], (L, D, 2 * D_FF), D ** -0.5),
        'ffn1_wo': nrm(ks[6], (L, D_FF, D), D_FF ** -0.5),
        'ffn2_wi': nrm(ks[7], (L, D, 2 * D_FF), D ** -0.5),
        'ffn2_wo': nrm(ks[8], (L, D_FF, D), D_FF ** -0.5),
        'w_in': nrm(ks[9], (L, D, IN_WIDTH), D ** -0.5),
        'hg_lb_logits': nrm(ks[10], (L, HG_WIDTH), 1.0),
        'hg_onorm': 1.0 + nrm(ks[11], (L, HG_DV), 0.01),
        'hg_proj': nrm(ks[12], (L, HG_WIDTH, D), HG_WIDTH ** -0.5),
        'ssm_a_re': -0.5 + nrm(ks[13], (L, G, N), 0.01),
        'ssm_a_im': math.pi * n_idx + nrm(ks[14], (L, G, N), 0.01),
        'ssm_log_dt': jax.random.uniform(ks[15], (L, G), f32, math.log(1e-3), math.log(1e-1)),
        'ssm_b_re': nrm(ks[16], (L, G, N, P), (2 * P) ** -0.5),
        'ssm_b_im': nrm(ks[17], (L, G, N, P), (2 * P) ** -0.5),
        'ssm_c_re': nrm(ks[18], (L, G, P, N), N ** -0.5),
        'ssm_c_im': nrm(ks[19], (L, G, P, N), N ** -0.5),
        'ssm_d': nrm(ks[20], (L, SSM_WIDTH), 1.0),
        'ssm_glu_w': nrm(ks[21], (L, SSM_WIDTH, 2 * D), SSM_WIDTH ** -0.5),
        'nsa_q_gain': 1.0 + nrm(ks[22], (L, NSA_DH), 0.01),
        'nsa_k_gain': 1.0 + nrm(ks[23], (L, NSA_DH), 0.01),
        'nsa_pe_k': nrm(ks[24], (L, CMP_LEN, NSA_DH), 0.1),
        'nsa_pe_v': nrm(ks[25], (L, CMP_LEN, NSA_DH), 0.1),
        'nsa_phi_k': nrm(ks[26], (L, CMP_LEN, NSA_DH, NSA_DH), (CMP_LEN * NSA_DH) ** -0.5),
        'nsa_phi_v': nrm(ks[27], (L, CMP_LEN, NSA_DH, NSA_DH), (CMP_LEN * NSA_DH) ** -0.5),
        'nsa_proj': nrm(ks[28], (L, NSA_WIDTH, D), NSA_WIDTH ** -0.5),
        'rel_table': nrm(ks[29], (REL_BUCKETS, NSA_HEADS), 0.5),
        'w_out': nrm(ks[30], (L, D, D), D ** -0.5),
    }


def reference(x, c, ada_w, ada_b, norm_g, ffn1_wi, ffn1_wo, ffn2_wi, ffn2_wo, w_in,
              hg_lb_logits, hg_onorm, hg_proj, ssm_a_re, ssm_a_im, ssm_log_dt, ssm_b_re, ssm_b_im,
              ssm_c_re, ssm_c_im, ssm_d, ssm_glu_w, nsa_q_gain, nsa_k_gain, nsa_pe_k, nsa_pe_v,
              nsa_phi_k, nsa_phi_v, nsa_proj, rel_table, w_out):
    lb_cum = jnp.cumsum(jax.nn.softmax(hg_lb_logits.astype(jnp.float32), axis=0), axis=0)
    lower_bounds = lb_cum - lb_cum[0:1]
    c_act = jax.nn.silu(c)
    h = x
    for l in range(DEPTH):
        mod = c_act @ ada_w[l] + ada_b[l]
        sh1, sc1, g1, sh2, sc2, g2, sh3, sc3, g3 = [m[:, None, :] for m in jnp.split(mod, 9, axis=-1)]
        u = modulate(rms_norm(h, norm_g[l, 0]), sh1, sc1)
        h = h + 0.5 * g1 * swiglu(u, ffn1_wi[l], ffn1_wo[l])
        u = modulate(rms_norm(h, norm_g[l, 1]), sh2, sc2)
        (hq, hf, hi, hg, su, nq_, kc_, vc_, ks_, vs_, kw_, vw_, ngate,
         za, zb, zc) = split_cols(u @ w_in[l], IN_SPLITS)
        y_a = hgrn2(hq, hf, hi, hg, lower_bounds[l], hg_onorm[l]).astype(u.dtype) @ hg_proj[l]
        y_s = s5_ssm(su, ssm_a_re[l], ssm_a_im[l], ssm_log_dt[l], ssm_b_re[l], ssm_b_im[l],
                     ssm_c_re[l], ssm_c_im[l], ssm_d[l])
        zz = jax.nn.gelu(y_s).astype(u.dtype) @ ssm_glu_w[l]
        y_b = zz[..., :D_MODEL] * jax.nn.sigmoid(zz[..., D_MODEL:])
        y_c = nsa_attention(nq_, kc_, vc_, ks_, vs_, kw_, vw_, ngate, nsa_q_gain[l], nsa_k_gain[l],
                            nsa_pe_k[l], nsa_pe_v[l], nsa_phi_k[l], nsa_phi_v[l],
                            rel_table).astype(u.dtype) @ nsa_proj[l]
        merged = jax.nn.sigmoid(za) * y_a + jax.nn.sigmoid(zb) * y_b + jax.nn.sigmoid(zc) * y_c
        h = h + g2 * (merged @ w_out[l])
        u = modulate(rms_norm(h, norm_g[l, 2]), sh3, sc3)
        h = h + 0.5 * g3 * swiglu(u, ffn2_wi[l], ffn2_wo[l])
    return h
```

```cpp
#include <hip/hip_runtime.h>
#include <cstdio>
#include <cstdint>
namespace pg8 {
#define PG8_LAS __attribute__((address_space(3)))
typedef unsigned short bf16_t;
typedef short bf16x8 __attribute__((ext_vector_type(8)));
typedef float f32x4 __attribute__((ext_vector_type(4)));
typedef unsigned u32x4 __attribute__((ext_vector_type(4)));
constexpr int BM = 256, BK = 64, HALF = 128, HTB = HALF * BK * 2  , STAGE_BYTES = 8 * HTB, NXCD = 8, WGM = 8;

__host__ __device__ __forceinline__ int lds_byte(int r, int c) { const int st = (r >> 4) * 2 + (c >> 5), rr = r & 15, cc = c & 31, ob = rr * 64 + cc * 2; return st * 1024 + (ob ^ (((ob >> 9) & 1) << 5)); }
__host__ __device__ __forceinline__ void stage_rc(int b, int& R, int& C) { const int st = b / 1024, sb = b % 1024, swz = sb ^ (((sb >> 9) & 1) << 5); R = (st >> 1) * 16 + swz / 64; C = (st & 1) * 32 + (swz % 64) / 2; }
__host__ __device__ __forceinline__ int perm32(int rho) { const int n = rho >> 4, i = rho & 15; return 8 * (i >> 2) + 4 * n + (i & 3); }

struct Unit { int pm, pn; };
struct Gemm { const bf16_t* A; const bf16_t* Bt; int M, N, K; };

struct StaticOrder {
    int nM, nN, nwg, G, c;
    __host__ __device__ void init(int M, int N, int G_, int c_) { nM = M / BM; nN = N / BM; nwg = nM * nN; G = G_; c = c_; }
    __host__ __device__ bool next(int i, Unit& u) const {
        const long L = (long)i * G + c; if (L >= nwg) return false;
        int wgid = (int)L; { const int q = nwg / NXCD, r = nwg % NXCD, xcd = wgid % NXCD, off = wgid / NXCD; wgid = (xcd < r ? xcd * (q + 1) : r * (q + 1) + (xcd - r) * q) + off; }
        const int nig = WGM * nN, gid = wgid / nig, fm = gid * WGM, gsz = (nM - fm) < WGM ? (nM - fm) : WGM;
        u.pm = fm + ((wgid % nig) % gsz); u.pn = (wgid % nig) / gsz; return true;
    }
    __device__ __forceinline__ void a_ready(const Unit&) const {}
    __device__ __forceinline__ void done(const Unit&) const {}
};
typedef float pg8_f32x2_t __attribute__((ext_vector_type(2)));
typedef __bf16 pg8_bf16x2_t __attribute__((ext_vector_type(2)));
__device__ __forceinline__ unsigned cvt_pk_bf16(float lo, float hi) { const pg8_f32x2_t v = {lo, hi}; return __builtin_bit_cast(unsigned, __builtin_convertvector(v, pg8_bf16x2_t)); }
typedef float f32x2 __attribute__((ext_vector_type(2)));
template <class Epi, class Sched, bool ALIGN_EPI = false, bool SP2 = false>
__device__ __forceinline__ void gemm_phase(PG8_LAS unsigned char* lds, const Gemm g, const Sched& S, const Epi& E) {
    int tid_ = threadIdx.x; asm volatile("" : "+v"(tid_));
    const int tid = tid_, wid = __builtin_amdgcn_readfirstlane(tid >> 6), lane = tid & 63, wr = wid >> 2, wc = wid & 3, fr = lane & 15, fq = lane >> 4;
    const int K = g.K, nt = K / BK;
    unsigned voffA[2], voffB[2];
#pragma unroll
    for (int i = 0; i < 2; ++i) { int R, C; stage_rc(tid * 16 + i * 8192, R, C); const int Rb = Epi::PERM ? ((R & ~31) + perm32(R & 31)) : R;
        voffA[i] = (unsigned)(R * K + C) * 2u; voffB[i] = (unsigned)(Rb * K + C) * 2u; }
    const size_t kstep = (size_t)(BK * 2);
    const size_t hstep = (size_t)HALF * K * 2;
    const size_t tstep = 2 * hstep;
    const unsigned ldsw = (unsigned)wid * 1024u;
    const int aoff = lds_byte(wr * 64 + fr, fq * 8), boff = lds_byte(wc * 32 + fr, fq * 8);
#define PG8_SA(b, h) (((b) * 2 + (h)) * HTB)
#define PG8_SB(b, h) ((4 + (b) * 2 + (h)) * HTB)
#define PG8_STAGE(bufoff, gbase, voff) do { _Pragma("unroll") for (int _i = 0; _i < 2; ++_i) \
        __builtin_amdgcn_global_load_lds((const unsigned*)((const char*)(gbase) + (voff)[_i]), (PG8_LAS unsigned*)(lds + (bufoff) + ldsw + _i * 8192), 16, 0, 0); } while (0)
#define PG8_LDA(dst, b, h) do { _Pragma("unroll") for (int m = 0; m < 4; ++m) _Pragma("unroll") for (int k = 0; k < 2; ++k) dst[m][k] = *(const PG8_LAS bf16x8*)(lds + PG8_SA(b, h) + aoff + m * 2048 + k * 1024); } while (0)
#define PG8_LDB(dst, b, h) do { _Pragma("unroll") for (int n = 0; n < 2; ++n) _Pragma("unroll") for (int k = 0; k < 2; ++k) dst[n][k] = *(const PG8_LAS bf16x8*)(lds + PG8_SB(b, h) + boff + n * 2048 + k * 1024); } while (0)
#define PG8_MMA(ai, bj, At, Bt) do { __builtin_amdgcn_s_setprio(1); _Pragma("unroll") for (int m = 0; m < 4; ++m) _Pragma("unroll") for (int n = 0; n < 2; ++n) _Pragma("unroll") for (int k = 0; k < 2; ++k) \
        acc[ai][bj][m][n] = __builtin_amdgcn_mfma_f32_16x16x32_bf16(Bt[n][k], At[m][k], acc[ai][bj][m][n], 0, 0, 0); __builtin_amdgcn_s_setprio(0); } while (0)
#define PG8_WAIT_V(n) asm volatile("s_waitcnt vmcnt(" #n ")" ::: "memory")
#define PG8_WAIT_L(n) asm volatile("s_waitcnt lgkmcnt(" #n ")" ::: "memory")
#define PG8_BAR __builtin_amdgcn_s_barrier()
#define PG8_SCHED __builtin_amdgcn_sched_barrier(0)
    Unit cur, nxt; int ui = 0;
    if (!S.next(0, cur)) return;
    f32x4 acc[2][2][4][2];
#pragma unroll
    for (int a = 0; a < 2; ++a)
#pragma unroll
        for (int b = 0; b < 2; ++b)
#pragma unroll
            for (int m = 0; m < 4; ++m)
#pragma unroll
                for (int n = 0; n < 2; ++n) acc[a][b][m][n] = (f32x4){0.f, 0.f, 0.f, 0.f};
    bf16x8 At[4][2], B0[2][2], B1[2][2];
    const char* cA = (const char*)g.A + (size_t)cur.pm * tstep; const char* cB = (const char*)g.Bt + (size_t)cur.pn * tstep;
    S.a_ready(cur);
    if constexpr (SP2) {
        PG8_STAGE(PG8_SB(0, 0), cB, voffB); PG8_STAGE(PG8_SB(0, 1), cB + hstep, voffB); PG8_STAGE(PG8_SA(0, 0), cA, voffA); PG8_STAGE(PG8_SA(0, 1), cA + hstep, voffA);
        if (wr == 1) PG8_BAR;
        PG8_WAIT_V(2); PG8_BAR;
        PG8_STAGE(PG8_SB(1, 0), cB + kstep, voffB); PG8_STAGE(PG8_SA(1, 0), cA + kstep, voffA); PG8_STAGE(PG8_SB(1, 1), cB + hstep + kstep, voffB);
        PG8_WAIT_V(6); PG8_BAR;
    } else {
        PG8_STAGE(PG8_SB(0, 0), cB, voffB); PG8_STAGE(PG8_SA(0, 0), cA, voffA); PG8_STAGE(PG8_SB(0, 1), cB + hstep, voffB); PG8_STAGE(PG8_SA(0, 1), cA + hstep, voffA);
        if (wr == 1) PG8_BAR;
        PG8_WAIT_V(4); PG8_BAR;
        PG8_STAGE(PG8_SB(1, 0), cB + kstep, voffB); PG8_STAGE(PG8_SA(1, 0), cA + kstep, voffA); PG8_STAGE(PG8_SB(1, 1), cB + hstep + kstep, voffB);
        PG8_WAIT_V(6); PG8_BAR;
    }
    for (;;) {
        const bool has_next = S.next(ui + 1, nxt);
        const char* nA = has_next ? (const char*)g.A + (size_t)nxt.pm * tstep : cA; const char* nB = has_next ? (const char*)g.Bt + (size_t)nxt.pn * tstep : cB;
        for (int t = 0; t < nt; t += 2) {
            const bool last = (t == nt - 2);
            const char* a1 = cA + (size_t)(t + 1) * kstep;
            const char* a2 = last ? nA : cA + (size_t)(t + 2) * kstep; const char* b2 = last ? nB : cB + (size_t)(t + 2) * kstep;
            const char* a3 = a2 + kstep; const char* b3 = b2 + kstep;
            if (last && has_next) S.a_ready(nxt);
            if constexpr (SP2) {
            PG8_LDB(B0, 0, 0); PG8_LDB(B1, 0, 1); PG8_SCHED; PG8_LDA(At, 0, 0); PG8_STAGE(PG8_SA(1, 1), a1 + hstep, voffA);
            PG8_WAIT_V(8); PG8_WAIT_L(0); PG8_BAR; PG8_MMA(0, 0, At, B0); PG8_MMA(0, 1, At, B1); PG8_BAR; PG8_SCHED;
            PG8_LDA(At, 0, 1); PG8_STAGE(PG8_SB(0, 0), b2, voffB); PG8_STAGE(PG8_SB(0, 1), b2 + hstep, voffB); PG8_STAGE(PG8_SA(0, 0), a2, voffA);
            PG8_WAIT_V(8); PG8_WAIT_L(0); PG8_BAR; PG8_MMA(1, 0, At, B0); PG8_MMA(1, 1, At, B1); PG8_BAR; PG8_SCHED;
            PG8_LDB(B0, 1, 0); PG8_LDB(B1, 1, 1); PG8_SCHED; PG8_LDA(At, 1, 0); PG8_STAGE(PG8_SA(0, 1), a2 + hstep, voffA);
            PG8_WAIT_V(8); PG8_WAIT_L(0); PG8_BAR; PG8_MMA(0, 0, At, B0); PG8_MMA(0, 1, At, B1); PG8_BAR; PG8_SCHED;
            PG8_LDA(At, 1, 1); PG8_STAGE(PG8_SB(1, 0), b3, voffB); PG8_STAGE(PG8_SB(1, 1), b3 + hstep, voffB); PG8_STAGE(PG8_SA(1, 0), a3, voffA);
            PG8_WAIT_V(8); PG8_WAIT_L(0); PG8_BAR; PG8_MMA(1, 0, At, B0); PG8_MMA(1, 1, At, B1); PG8_BAR; PG8_SCHED;
            } else {
            PG8_LDB(B0, 0, 0); PG8_SCHED; PG8_LDA(At, 0, 0); PG8_STAGE(PG8_SA(1, 1), a1 + hstep, voffA);
            PG8_WAIT_L(8); PG8_BAR; PG8_WAIT_L(0); PG8_MMA(0, 0, At, B0); PG8_BAR; PG8_SCHED;
            PG8_LDB(B1, 0, 1); PG8_STAGE(PG8_SB(0, 0), b2, voffB);
            PG8_BAR; PG8_WAIT_L(0); PG8_MMA(0, 1, At, B1); PG8_BAR;
            PG8_LDA(At, 0, 1); PG8_STAGE(PG8_SA(0, 0), a2, voffA);
            PG8_BAR; PG8_WAIT_L(0); PG8_MMA(1, 0, At, B0); PG8_BAR; PG8_SCHED;
            PG8_STAGE(PG8_SB(0, 1), b2 + hstep, voffB);
            PG8_WAIT_V(6); PG8_BAR; PG8_MMA(1, 1, At, B1); PG8_BAR;
            PG8_LDB(B0, 1, 0); PG8_SCHED; PG8_LDA(At, 1, 0); PG8_STAGE(PG8_SA(0, 1), a2 + hstep, voffA);
            PG8_WAIT_L(8); PG8_BAR; PG8_WAIT_L(0); PG8_MMA(0, 0, At, B0); PG8_BAR; PG8_SCHED;
            PG8_LDB(B1, 1, 1); PG8_STAGE(PG8_SB(1, 0), b3, voffB);
            PG8_BAR; PG8_WAIT_L(0); PG8_MMA(0, 1, At, B1); PG8_BAR;
            PG8_LDA(At, 1, 1); PG8_STAGE(PG8_SA(1, 0), a3, voffA);
            PG8_BAR; PG8_WAIT_L(0); PG8_MMA(1, 0, At, B0); PG8_BAR; PG8_SCHED;
            PG8_STAGE(PG8_SB(1, 1), b3 + hstep, voffB);
            PG8_WAIT_V(6); PG8_BAR; PG8_MMA(1, 1, At, B1); PG8_BAR;
            }
        }
        if constexpr (ALIGN_EPI) { if (wr == 0) PG8_BAR; }
        if constexpr (!Epi::AFTER_DRAIN) { E(acc, cur, wr, wc, fr, fq); S.done(cur); }
        if (!has_next) break;
#pragma unroll
        for (int a = 0; a < 2; ++a)
#pragma unroll
            for (int b = 0; b < 2; ++b)
#pragma unroll
                for (int m = 0; m < 4; ++m)
#pragma unroll
                    for (int n = 0; n < 2; ++n) acc[a][b][m][n] = (f32x4){0.f, 0.f, 0.f, 0.f};
        cur = nxt; cA = nA; cB = nB; ++ui;
        if constexpr (ALIGN_EPI) { if (wr == 1) PG8_BAR; }
    }
    PG8_WAIT_V(0);
    if constexpr (!ALIGN_EPI) { if (wr == 0) PG8_BAR; }
    PG8_BAR;
    if constexpr (Epi::AFTER_DRAIN) { E.fused(acc, cur, wr, wc, fr, fq, lds, wid, lane); S.done(cur); }
#undef PG8_SA
#undef PG8_SB
#undef PG8_STAGE
#undef PG8_LDA
#undef PG8_LDB
#undef PG8_MMA
#undef PG8_WAIT_V
#undef PG8_WAIT_L
#undef PG8_BAR
#undef PG8_SCHED
}
}

#define GAS __attribute__((address_space(1)))
#define LAS __attribute__((address_space(3)))
typedef unsigned short bf16;
typedef unsigned u32x4 __attribute__((ext_vector_type(4)));
typedef unsigned u32x2 __attribute__((ext_vector_type(2)));
typedef float f32x4 __attribute__((ext_vector_type(4)));

constexpr int D = 2048, BATCH = 8, SEQ = 2048, M = BATCH * SEQ, DEPTH = 2, DFF = 5632;
constexpr int INW = 11312, ZP = 11520;
constexpr int C_HQ = 0, C_HF = 512, C_HI = 1024, C_HG = 1536, C_SU = 2048, C_NQ = 2560, C_KC = 3584, C_VC = 3840, C_KS = 4096, C_VS = 4352,
              C_KW = 4608, C_VW = 4864, C_ZA = 5120, C_ZB = 7168, C_ZC = 9216, C_NG = 11264;
constexpr int NG_SRC = 5120, NGW_ = 48;
constexpr int MODW = 9 * D;
constexpr float EPS = 1e-6f;
constexpr int NCMP = 127;
constexpr int NWAVES = 8;

constexpr size_t MiB = 1u << 20;
constexpr size_t WS_CTL = 0, CTL_ZERO_BYTES = 64 * 1024;
constexpr size_t WS_MOD = 1 * MiB;
constexpr size_t WS_SMALL = 3 * MiB;
constexpr size_t WS_KCH = 4 * MiB, WS_KCL = 4 * MiB + 512 * 1024, WS_VCT = 5 * MiB;
constexpr size_t WS_PHIT = 6 * MiB;
constexpr size_t WS_PEC = 7 * MiB;
constexpr size_t WS_W = 8 * MiB;
constexpr size_t W_WI1 = 0, SZ_WI = (size_t)2 * DFF * D * 2, SZ_WO = (size_t)D * DFF * 2;
constexpr size_t W_WO1 = W_WI1 + SZ_WI, W_WI2 = W_WO1 + SZ_WO, W_WO2 = W_WI2 + SZ_WI, W_WIN = W_WO2 + SZ_WO, SZ_WIN = (size_t)ZP * D * 2;
constexpr size_t W_HGP = W_WIN + SZ_WIN, W_GLU = W_HGP + (size_t)D * 512 * 2, W_NSP = W_GLU + (size_t)4096 * 512 * 2, W_WOUT = W_NSP + (size_t)D * 1024 * 2;
constexpr size_t LAYER_W = W_WOUT + (size_t)D * D * 2;
constexpr size_t WS_U = WS_W + 2 * LAYER_W;
constexpr size_t WS_ACT = WS_U + (size_t)M * D * 2;
constexpr size_t WS_Z = WS_ACT + (size_t)M * DFF * 2;
constexpr size_t WS_ORAW = WS_Z + (size_t)M * ZP * 2;
constexpr size_t WS_OA = WS_ACT + (size_t)M * D * 4;
constexpr size_t WS_YSG = WS_OA + (size_t)M * 512 * 2;
static_assert(WS_YSG + (size_t)M * 512 * 2 <= WS_ACT + (size_t)M * DFF * 2, "OA/YSG inside ACT");
constexpr size_t WS_HGDD = WS_YSG + (size_t)M * 512 * 2;
static_assert(WS_HGDD + (size_t)32 * 64 * 128 * 4 <= WS_ACT + (size_t)M * DFF * 2, "HGDD inside ACT");
constexpr size_t WS_OC = WS_ORAW + (size_t)M * 512 * 4;
constexpr size_t WS_VST = WS_OC + (size_t)M * 1024 * 2;
constexpr size_t WS_VWT = WS_VST + (size_t)8 * 4 * 64 * SEQ * 2;
constexpr size_t S5BT_L = (size_t)32 * 512 * 640 * 2, S5WT_L = (size_t)32 * 128 * 512 * 2, S5AL_L = 32 * 64 * 2 * 4;
constexpr size_t WS_S5BT = WS_VWT + (size_t)8 * 4 * 64 * SEQ * 2;
constexpr size_t WS_S5AE = WS_S5BT + 2 * S5BT_L;
constexpr size_t WS_S5WT = WS_S5AE + S5BT_L;
constexpr size_t WS_S5AL = WS_S5WT + 2 * S5WT_L;
constexpr size_t WS_END = WS_S5AL + 2 * S5AL_L;
static_assert(WS_END <= (size_t)1152 * MiB, "workspace map exceeds the guaranteed size");
static_assert((WS_U % 256) == 0 && (WS_ACT % 256) == 0 && (WS_Z % 256) == 0 && (WS_ORAW % 256) == 0, "alignment");

constexpr int CW_BAR = 1024;
constexpr int RING_BYTES = 131072, MISC_OFF = RING_BYTES + 320, LDS_BYTES = 147456;

__device__ __forceinline__ float bf2f(unsigned short b) { return __uint_as_float(((unsigned)b) << 16); }
__device__ __forceinline__ float bflo(unsigned w) { return __uint_as_float(w << 16); }
__device__ __forceinline__ float bfhi(unsigned w) { return __uint_as_float(w & 0xffff0000u); }
__device__ __forceinline__ unsigned f2bf(float f) { unsigned u = __float_as_uint(f); return (u + 0x7fffu + ((u >> 16) & 1u)) >> 16; }
__device__ __forceinline__ unsigned pk2(float lo, float hi) { return pg8::cvt_pk_bf16(lo, hi); }
__device__ __forceinline__ float sigm(float x) { return __builtin_amdgcn_rcpf(1.0f + __expf(-x)); }
__device__ __forceinline__ float siluf(float x) { return x * __builtin_amdgcn_rcpf(1.0f + __expf(-x)); }
__device__ __forceinline__ float gelu_tanh(float y) { const float a = 0.7978845608028654f * (y + 0.044715f * y * y * y); const float e = __expf(2.0f * a); const float th = 1.0f - 2.0f * __builtin_amdgcn_rcpf(e + 1.0f); return 0.5f * y * (1.0f + th); }
__device__ __forceinline__ float wave_sum(float v) {
#pragma unroll
    for (int o = 1; o < 64; o <<= 1) v += __shfl_xor(v, o);
    return v;
}
#define LDS_WAIT() asm volatile("s_waitcnt lgkmcnt(0)" ::: "memory")

#define XB_TMO      128
#define XB_XCNT(j)  (256  + 64 * (j))
#define XB_XSUB(j)  (1280 + 64 * (j))
#define XB_XGEN(j)  (2304 + 64 * (j))
#define XB_TOP      3328
#define XB_TOPGEN   3392
#define XCD_BAR_WORDS 3456
#define XB_SPIN_CAP (1u << 22)
__device__ __forceinline__ unsigned xb_ld(unsigned* p)              { return __hip_atomic_load(p, __ATOMIC_RELAXED, __HIP_MEMORY_SCOPE_AGENT); }
__device__ __forceinline__ unsigned xb_add(unsigned* p, unsigned v) { return __hip_atomic_fetch_add(p, v, __ATOMIC_RELAXED, __HIP_MEMORY_SCOPE_AGENT); }
__device__ __forceinline__ unsigned xb_xcc_id() { return (unsigned)__builtin_amdgcn_s_getreg((3 << 11) | 20) & 0xFu; }
#define XB_SPIN(cond, bar) do { unsigned _sp = 0; while (cond) { __builtin_amdgcn_s_sleep(1); \
    if ((++_sp & 255u) == 0u) { if (xb_ld(&(bar)[XB_TMO])) break; if (_sp > XB_SPIN_CAP) { atomicAdd(&(bar)[XB_TMO], 1u); break; } } } } while (0)
struct XcdBarrier { unsigned* bar; unsigned x; volatile LAS unsigned* st; };
__device__ __forceinline__ XcdBarrier xcd_barrier_post(unsigned* bar, volatile LAS unsigned* st) {
    XcdBarrier b; b.bar = bar; b.x = xb_xcc_id(); b.st = st;
    if (threadIdx.x == 0) (void)xb_add(&bar[XB_XCNT(b.x)], 1u);
    return b;
}
__device__ __forceinline__ void xcd_barrier_complete(unsigned* bar, unsigned x, unsigned& nloc, unsigned& nx) {
    const unsigned G = gridDim.x * gridDim.y * gridDim.z;
    unsigned sum, cnt, mine, sp = 0u;
    for (;;) {
        sum = 0u; cnt = 0u; mine = 0u;
#pragma unroll
        for (unsigned j = 0; j < 16; ++j) { const unsigned c = xb_ld(&bar[XB_XCNT(j)]); sum += c; cnt += (c > 0u) ? 1u : 0u; mine = (j == x) ? c : mine; }
        if (sum == G) break;
        __builtin_amdgcn_s_sleep(1);
        if ((++sp & 255u) == 0u) { if (xb_ld(&bar[XB_TMO])) break; if (sp > XB_SPIN_CAP) { atomicAdd(&bar[XB_TMO], 1u); break; } }
    }
    nloc = mine > 0u ? mine : 1u; nx = cnt > 0u ? cnt : 1u;
}
__device__ __forceinline__ void xcd_barrier(const XcdBarrier& b) {
    asm volatile("s_waitcnt vmcnt(0)" ::: "memory");
    __syncthreads();
    if (threadIdx.x == 0) {
        unsigned* bar = b.bar;
        __builtin_amdgcn_s_waitcnt(0);
        unsigned nloc = b.st[0], nx = b.st[1];
        if (nloc == 0u) { xcd_barrier_complete(bar, b.x, nloc, nx); b.st[0] = nloc; b.st[1] = nx; }
        const unsigned old = xb_add(&bar[XB_XSUB(b.x)], 1u);
        const unsigned gen = old / nloc;
        if (old + 1u == (gen + 1u) * nloc) {
            __builtin_amdgcn_fence(__ATOMIC_RELEASE, "agent");
            asm volatile("s_waitcnt vmcnt(0)" ::: "memory");
            const unsigned og = xb_add(&bar[XB_TOP], 1u);
            const unsigned tg = og / nx;
            if (og + 1u == (tg + 1u) * nx) xb_add(&bar[XB_TOPGEN], 1u);
            else XB_SPIN(xb_ld(&bar[XB_TOPGEN]) == tg, bar);
            __builtin_amdgcn_fence(__ATOMIC_ACQUIRE, "agent");
            xb_add(&bar[XB_XGEN(b.x)], 1u);
            asm volatile("s_waitcnt vmcnt(0)" ::: "memory");
        } else {
            XB_SPIN(xb_ld(&bar[XB_XGEN(b.x)]) == gen, bar);
            __builtin_amdgcn_fence(__ATOMIC_ACQUIRE, "agent");
            asm volatile("s_waitcnt vmcnt(0)" ::: "memory");
        }
    }
    __syncthreads();
}

using pg8::Unit; using pg8::cvt_pk_bf16;
struct EpiStoreBf16 {
    static constexpr bool PERM = true, AFTER_DRAIN = false;
    bf16* O; int ldc;
    __device__ __forceinline__ void operator()(const f32x4 (&acc)[2][2][4][2], const Unit& u, int wr, int wc, int fr, int fq) const {
        const int row0 = u.pm * 256 + wr * 64 + fr, col0 = u.pn * 256 + wc * 32 + 8 * fq;
#pragma unroll
        for (int ai = 0; ai < 2; ++ai)
#pragma unroll
            for (int m = 0; m < 4; ++m) { bf16* rowp = O + (size_t)(row0 + ai * 128 + m * 16) * ldc + col0;
#pragma unroll
                for (int bj = 0; bj < 2; ++bj) { const f32x4 v0 = acc[ai][bj][m][0], v1 = acc[ai][bj][m][1];
                    u32x4 w; w.x = cvt_pk_bf16(v0[0], v0[1]); w.y = cvt_pk_bf16(v0[2], v0[3]); w.z = cvt_pk_bf16(v1[0], v1[1]); w.w = cvt_pk_bf16(v1[2], v1[3]);
                    *(u32x4*)(rowp + bj * 128) = w; } }
    }
};
struct EpiSwiGLU {
    static constexpr bool PERM = true, AFTER_DRAIN = false;
    bf16* O; int ldc;
    __device__ __forceinline__ void operator()(const f32x4 (&acc)[2][2][4][2], const Unit& u, int wr, int wc, int fr, int fq) const {
        const int row0 = u.pm * 256 + wr * 64 + fr, col0 = u.pn * 128 + wc * 32 + 8 * fq;
#pragma unroll
        for (int ai = 0; ai < 2; ++ai)
#pragma unroll
            for (int m = 0; m < 4; ++m) { bf16* rowp = O + (size_t)(row0 + ai * 128 + m * 16) * ldc + col0;
                float r[8];
#pragma unroll
                for (int n = 0; n < 2; ++n)
#pragma unroll
                    for (int j = 0; j < 4; ++j) { const float g = acc[ai][0][m][n][j], up = acc[ai][1][m][n][j]; r[n * 4 + j] = siluf(g) * up; }
                u32x4 w; w.x = cvt_pk_bf16(r[0], r[1]); w.y = cvt_pk_bf16(r[2], r[3]); w.z = cvt_pk_bf16(r[4], r[5]); w.w = cvt_pk_bf16(r[6], r[7]);
                *(u32x4*)rowp = w; }
    }
};
struct EpiResid {
    static constexpr bool PERM = false, AFTER_DRAIN = false;
    const float* hin; float* hout; const float* gate; float scale;
    __device__ __forceinline__ void operator()(const f32x4 (&acc)[2][2][4][2], const Unit& u, int wr, int wc, int fr, int fq) const {
        const int row0 = u.pm * 256 + wr * 64 + fr, col0 = u.pn * 256 + wc * 32 + 4 * fq, b = u.pm >> 3;
        f32x4 gv[2][2];
#pragma unroll
        for (int bj = 0; bj < 2; ++bj)
#pragma unroll
            for (int n = 0; n < 2; ++n) gv[bj][n] = *(const f32x4*)(gate + (size_t)b * MODW + col0 + bj * 128 + n * 16) * scale;
#pragma unroll
        for (int ai = 0; ai < 2; ++ai)
#pragma unroll
            for (int m = 0; m < 4; ++m) { const size_t off = (size_t)(row0 + ai * 128 + m * 16) * D + col0;
#pragma unroll
                for (int bj = 0; bj < 2; ++bj)
#pragma unroll
                    for (int n = 0; n < 2; ++n) { const f32x4 hv = *(const f32x4*)(hin + off + bj * 128 + n * 16);
                        *(f32x4*)(hout + off + bj * 128 + n * 16) = hv + gv[bj][n] * acc[ai][bj][m][n]; } }
    }
};
__device__ __forceinline__ void sig8(const u32x4 w, float (&s)[8]) {
    s[0] = sigm(bflo(w.x)); s[1] = sigm(bfhi(w.x)); s[2] = sigm(bflo(w.y)); s[3] = sigm(bfhi(w.y));
    s[4] = sigm(bflo(w.z)); s[5] = sigm(bfhi(w.z)); s[6] = sigm(bflo(w.w)); s[7] = sigm(bfhi(w.w));
}
struct EpiMergeB {
    static constexpr bool PERM = true, AFTER_DRAIN = false;
    const bf16* zg; bf16* O;
    __device__ __forceinline__ void operator()(const f32x4 (&acc)[2][2][4][2], const Unit& u, int wr, int wc, int fr, int fq) const {
        const int row0 = u.pm * 256 + wr * 64 + fr, col0 = u.pn * 128 + wc * 32 + 8 * fq;
#pragma unroll
        for (int ai = 0; ai < 2; ++ai)
#pragma unroll
            for (int m = 0; m < 4; ++m) { const int row = row0 + ai * 128 + m * 16;
                const u32x4 w = *(const u32x4*)(zg + (size_t)row * ZP + col0); float s[8]; sig8(w, s);
                float v[8];
#pragma unroll
                for (int j = 0; j < 4; ++j) { v[j] = s[j] * acc[ai][0][m][0][j] * sigm(acc[ai][1][m][0][j]); v[4 + j] = s[4 + j] * acc[ai][0][m][1][j] * sigm(acc[ai][1][m][1][j]); }
                u32x4 o; o.x = cvt_pk_bf16(v[0], v[1]); o.y = cvt_pk_bf16(v[2], v[3]); o.z = cvt_pk_bf16(v[4], v[5]); o.w = cvt_pk_bf16(v[6], v[7]);
                *(u32x4*)(O + (size_t)row * D + col0) = o; }
    }
};
struct EpiMergeAcc {
    static constexpr bool PERM = true, AFTER_DRAIN = false;
    const bf16* zg; bf16* O;
    __device__ __forceinline__ void operator()(const f32x4 (&acc)[2][2][4][2], const Unit& u, int wr, int wc, int fr, int fq) const {
        const int row0 = u.pm * 256 + wr * 64 + fr, col0 = u.pn * 256 + wc * 32 + 8 * fq;
#pragma unroll
        for (int ai = 0; ai < 2; ++ai)
#pragma unroll
            for (int m = 0; m < 4; ++m) { const int row = row0 + ai * 128 + m * 16;
#pragma unroll
                for (int bj = 0; bj < 2; ++bj) { const u32x4 w = *(const u32x4*)(zg + (size_t)row * ZP + col0 + bj * 128); float s[8]; sig8(w, s);
                    bf16* op = O + (size_t)row * D + col0 + bj * 128;
                    const u32x4 p = *(const u32x4*)op;
                    const f32x4 a = acc[ai][bj][m][0], c = acc[ai][bj][m][1];
                    u32x4 o; o.x = cvt_pk_bf16(bflo(p.x) + s[0] * a[0], bfhi(p.x) + s[1] * a[1]); o.y = cvt_pk_bf16(bflo(p.y) + s[2] * a[2], bfhi(p.y) + s[3] * a[3]);
                    o.z = cvt_pk_bf16(bflo(p.z) + s[4] * c[0], bfhi(p.z) + s[5] * c[1]); o.w = cvt_pk_bf16(bflo(p.w) + s[6] * c[2], bfhi(p.w) + s[7] * c[3]);
                    *(u32x4*)op = o; } }
    }
};

__device__ __forceinline__ void transpose_item(const float* W, int K, int N, int Npad, bf16* WT, int maptype, int H, int item, int lane) {
    const int nblk = Npad / 64, kb = item / nblk, nb = item - kb * nblk, k0 = 64 * kb, n0 = 64 * nb;
    const int nn = n0 + lane; const bool ok = nn < N;
    const float* src = W + (size_t)k0 * N + (ok ? nn : 0);
    float v[64];
#pragma unroll
    for (int i = 0; i < 64; ++i) v[i] = __builtin_nontemporal_load(src + (size_t)i * N);
    int d0 = n0;
    if (maptype == 1) { const int hb = n0 / H, rem = n0 - hb * H; d0 = (rem >> 7) * 256 + hb * 128 + (rem & 127); }
    int drow = d0 + lane;
    if (maptype == 2) drow = (nn >= N || nn < NG_SRC) ? nn : (nn < NG_SRC + NGW_ ? C_NG + (nn - NG_SRC) : nn - NGW_);
    u32x4* dst = (u32x4*)(WT + (size_t)drow * K + k0);
#pragma unroll
    for (int j = 0; j < 8; ++j) { u32x4 o;
        o.x = ok ? pk2(v[8 * j + 0], v[8 * j + 1]) : 0u; o.y = ok ? pk2(v[8 * j + 2], v[8 * j + 3]) : 0u; o.z = ok ? pk2(v[8 * j + 4], v[8 * j + 5]) : 0u; o.w = ok ? pk2(v[8 * j + 6], v[8 * j + 7]) : 0u;
        dst[j] = o; }
}

struct Args { const float* in[31]; float* out; unsigned char* ws; };
#define KIN(i) (((const float* const*)__builtin_amdgcn_kernarg_segment_ptr())[(i)])
#define KOUT() (((float* const*)__builtin_amdgcn_kernarg_segment_ptr())[31])
#define KWS() (((unsigned char* const*)__builtin_amdgcn_kernarg_segment_ptr())[32])

__device__ __forceinline__ void prologue_transposes(int l, LAS unsigned char* lds, int gw, int NGW, int wave, int lane) {
    constexpr int I_WI = (D / 64) * (2 * DFF / 64), I_WO = (DFF / 64) * (D / 64), I_WIN = (D / 64) * (ZP / 64), I_HGP = (512 / 64) * (D / 64),
                  I_GLU = (512 / 64) * (4096 / 64), I_NSP = (1024 / 64) * (D / 64), I_WOUT = (D / 64) * (D / 64);
    constexpr int I_LAYER = 2 * (I_WI + I_WO) + I_WIN + I_HGP + I_GLU + I_NSP + I_WOUT;
    for (int it = gw; it < I_LAYER; it += NGW) {
        int r = it;
        const float* src; size_t woff; int K, N, Npad, mt = 0, H = 1;
        if (r < I_WI) { src = KIN(5) + (size_t)l * D * 2 * DFF; K = D; N = 2 * DFF; Npad = N; woff = W_WI1; mt = 1; H = DFF; }
        else if ((r -= I_WI) < I_WO) { src = KIN(6) + (size_t)l * DFF * D; K = DFF; N = D; Npad = N; woff = W_WO1; }
        else if ((r -= I_WO) < I_WI) { src = KIN(7) + (size_t)l * D * 2 * DFF; K = D; N = 2 * DFF; Npad = N; woff = W_WI2; mt = 1; H = DFF; }
        else if ((r -= I_WI) < I_WO) { src = KIN(8) + (size_t)l * DFF * D; K = DFF; N = D; Npad = N; woff = W_WO2; }
        else if ((r -= I_WO) < I_WIN) { src = KIN(9) + (size_t)l * D * INW; K = D; N = INW; Npad = ZP; woff = W_WIN; mt = 2; }
        else if ((r -= I_WIN) < I_HGP) { src = KIN(12) + (size_t)l * 512 * D; K = 512; N = D; Npad = N; woff = W_HGP; }
        else if ((r -= I_HGP) < I_GLU) { src = KIN(21) + (size_t)l * 512 * 4096; K = 512; N = 4096; Npad = N; woff = W_GLU; mt = 1; H = 2048; }
        else if ((r -= I_GLU) < I_NSP) { src = KIN(28) + (size_t)l * 1024 * D; K = 1024; N = D; Npad = N; woff = W_NSP; }
        else { r -= I_NSP; src = KIN(30) + (size_t)l * D * D; K = D; N = D; Npad = N; woff = W_WOUT; }
        transpose_item(src, K, N, Npad, (bf16*)(KWS() + WS_W + (size_t)l * LAYER_W + woff), mt, H, r, lane);
    }
}

__device__ __forceinline__ void prologue_mod(const Args& a, LAS unsigned char* lds, int tid, int G) {
    LAS float* cact = (LAS float*)lds;
    LAS float* red = (LAS float*)(lds + 65536);
    const float* c = KIN(1); const float* ada_w = KIN(2); const float* ada_b = KIN(3);
    float* mod = (float*)(KWS() + WS_MOD);
    for (int i = tid; i < BATCH * D; i += 512) { const int b = i / D, k = i - b * D; cact[k * 8 + b] = siluf(c[i]); }
    __syncthreads();
    for (int unit = blockIdx.x; unit < 256; unit += G) {
        const int l = unit >> 7, colbase = (unit & 127) * 144;
        const float* W = ada_w + (size_t)l * D * MODW + colbase;
        if (tid < 504) {
            const int c4 = tid % 36, kg = tid / 36;
            f32x4 acc[8];
#pragma unroll
            for (int b = 0; b < 8; ++b) acc[b] = (f32x4){0.f, 0.f, 0.f, 0.f};
#pragma unroll 4
            for (int k = kg; k < D; k += 14) {
                const f32x4 w = __builtin_nontemporal_load((const f32x4*)(W + (size_t)k * MODW + c4 * 4));
                const f32x4 ca0 = *(const LAS f32x4*)(cact + k * 8), ca1 = *(const LAS f32x4*)(cact + k * 8 + 4);
                acc[0] += w * ca0[0]; acc[1] += w * ca0[1]; acc[2] += w * ca0[2]; acc[3] += w * ca0[3];
                acc[4] += w * ca1[0]; acc[5] += w * ca1[1]; acc[6] += w * ca1[2]; acc[7] += w * ca1[3];
            }
#pragma unroll
            for (int b = 0; b < 8; ++b) *(LAS f32x4*)(red + (kg * 36 + c4) * 32 + b * 4) = acc[b];
        }
        __syncthreads();
        for (int o = tid; o < 36 * 32; o += 512) {
            const int c4 = o >> 5, r = o & 31; float s = 0.f;
#pragma unroll
            for (int kg = 0; kg < 14; ++kg) s += red[(kg * 36 + c4) * 32 + r];
            const int b = r >> 2, j = r & 3, col = colbase + c4 * 4 + j;
            mod[((size_t)l * 8 + b) * MODW + col] = s + ada_b[(size_t)l * MODW + col];
        }
        __syncthreads();
    }
}

__device__ __forceinline__ void prologue_small(const Args& a, int tid) {
    float* biasTab = (float*)(KWS() + WS_SMALL); float* lbv = biasTab + 128 * 16;
    const float* rel = KIN(29); const float* lbl = KIN(10);
    if (blockIdx.x == 0) {
        for (int i = tid; i < 128 * 16; i += 512) { const int d = i >> 4, hd = i & 15; int bk = d;
            if (d >= 16) { bk = 16 + (int)(logf((float)d / 16.0f) / logf(8.0f) * 16.0f); bk = bk < 31 ? bk : 31; }
            biasTab[i] = rel[bk * 16 + hd]; }
    }
    if (blockIdx.x == 1 % gridDim.x) {
        for (int i = tid; i < 512; i += 512) { const float a0 = lbl[i], a1 = lbl[512 + i], mx = fmaxf(a0, a1); const float e0 = expf(a0 - mx), e1 = expf(a1 - mx), s = e0 + e1;
            const float p0 = e0 / s, p1 = e1 / s; const float c0 = p0, c1 = p0 + p1; lbv[i] = c0 - c0; lbv[512 + i] = c1 - c0; }
    }
}

__device__ __forceinline__ void norm_phase(const float* h, const float* gain, const float* shift, const float* scale, bf16* U, int gw, int NGW, int lane) {
    for (int m0 = gw * 8; m0 < M; m0 += NGW * 8) {
        const int b = m0 / SEQ;
        f32x4 gg[8], sh[8];
#pragma unroll
        for (int j = 0; j < 8; ++j) { const int col = (lane + 64 * j) * 4;
            const f32x4 g = *(const f32x4*)(gain + col), sc = *(const f32x4*)(scale + (size_t)b * MODW + col); sh[j] = *(const f32x4*)(shift + (size_t)b * MODW + col);
#pragma unroll
            for (int e = 0; e < 4; ++e) gg[j][e] = g[e] * (1.0f + sc[e]); }
#pragma unroll 2
        for (int r = 0; r < 8; ++r) { const int m = m0 + r;
            const f32x4* xr = (const f32x4*)(h + (size_t)m * D) + lane;
            f32x4 v[8]; float ss = 0.f;
#pragma unroll
            for (int j = 0; j < 8; ++j) { v[j] = xr[64 * j]; ss += (v[j][0] * v[j][0] + v[j][1] * v[j][1]) + (v[j][2] * v[j][2] + v[j][3] * v[j][3]); }
            const float rstd = rsqrtf(wave_sum(ss) * (1.0f / D) + EPS);
            u32x2* o = (u32x2*)(U + (size_t)m * D) + lane;
#pragma unroll
            for (int j = 0; j < 8; ++j) { f32x4 y;
#pragma unroll
                for (int e = 0; e < 4; ++e) y[e] = (v[j][e] * rstd) * gg[j][e] + sh[j][e];
                u32x2 w; w.x = pk2(y[0], y[1]); w.y = pk2(y[2], y[3]); o[64 * j] = w; }
        }
    }
}

__device__ __forceinline__ void hgrn_phase(const bf16* z, const float* lbv, float* oraw, LAS unsigned char* lds, int tid, int G) {
    LAS float* red = (LAS float*)lds;
    LAS float* pb = (LAS float*)(lds + 34816);
    const int kq = tid >> 4, v = tid & 15, ptok = tid >> 5, pk = (tid & 31) * 4;
    __syncthreads();
    for (int unit = blockIdx.x; unit < 256; unit += G) {
        const int b = unit >> 5, h = (unit >> 3) & 3, vs = unit & 7;
        float lbp[4], omlp[4], s[4];
#pragma unroll
        for (int j = 0; j < 4; ++j) { lbp[j] = lbv[h * 128 + pk + j]; omlp[j] = 1.0f - lbp[j]; s[j] = 0.f; }
        const bf16* zq = z + ((size_t)b * SEQ + ptok) * ZP + C_HQ + h * 128 + pk;
        const bf16* zf = z + ((size_t)b * SEQ + ptok) * ZP + C_HF + h * 128 + pk;
        const bf16* zi = z + (size_t)(b * SEQ) * ZP + C_HI + h * 128 + vs * 16 + v;
#define HG_PREP(c_, buf_) do { const size_t o_ = (size_t)(c_) * 16 * ZP; const u32x2 q2 = *(const u32x2*)(zq + o_), f2 = *(const u32x2*)(zf + o_); \
            const float qv_[4] = {bflo(q2.x), bfhi(q2.x), bflo(q2.y), bfhi(q2.y)}, fv_[4] = {bflo(f2.x), bfhi(f2.x), bflo(f2.y), bfhi(f2.y)}; f32x4 F_, K_, Q_; \
            _Pragma("unroll") for (int j = 0; j < 4; ++j) { const float x_ = fminf(fmaxf(fv_[j], -30.f), 30.f); const float e_ = __expf(-x_), r_ = __builtin_amdgcn_rcpf(1.0f + e_); \
                F_[j] = lbp[j] + omlp[j] * r_; K_[j] = omlp[j] * (e_ * r_); Q_[j] = siluf(qv_[j]); } \
            LAS float* d_ = pb + (buf_) * 6144 + ptok * 128 + pk; *(LAS f32x4*)d_ = F_; *(LAS f32x4*)(d_ + 2048) = K_; *(LAS f32x4*)(d_ + 4096) = Q_; } while (0)
        HG_PREP(0, 0);
        unsigned short ri[16];
#pragma unroll
        for (int tt = 0; tt < 16; ++tt) ri[tt] = zi[(size_t)tt * ZP];
        __syncthreads();
        for (int c = 0; c < SEQ / 16; ++c) {
            const int cn = (c + 1 < SEQ / 16) ? c + 1 : c;
            if (c + 1 < SEQ / 16) HG_PREP(c + 1, (c + 1) & 1);
            const LAS float* tb_ = pb + (c & 1) * 6144 + kq * 4;
#pragma unroll
            for (int tt = 0; tt < 16; ++tt) {
                const f32x4 F = *(const LAS f32x4*)(tb_ + tt * 128), K = *(const LAS f32x4*)(tb_ + 2048 + tt * 128), Q = *(const LAS f32x4*)(tb_ + 4096 + tt * 128);
                const float iv = bf2f(ri[tt]); ri[tt] = zi[(size_t)(cn * 16 + tt) * ZP];
                float part = 0.f;
#pragma unroll
                for (int j = 0; j < 4; ++j) { s[j] = F[j] * s[j] + K[j] * iv; part += Q[j] * s[j]; }
                red[tt * 528 + kq * 16 + v] = part;
            }
            __syncthreads();
            if (tid < 256) { const int tt = tid >> 4, vv = tid & 15; float sum = 0.f;
#pragma unroll
                for (int k2 = 0; k2 < 32; ++k2) sum += red[tt * 528 + k2 * 16 + vv];
                oraw[(size_t)(b * SEQ + c * 16 + tt) * 512 + h * 128 + vs * 16 + vv] = sum; }
            __syncthreads();
        }
#undef HG_PREP
    }
}
__device__ __forceinline__ void hgrn_post_phase(const float* oraw, const bf16* z, const float* onorm, bf16* oa, int gw, int NGW, int lane) {
    const float g0 = onorm[2 * lane], g1 = onorm[2 * lane + 1];
    for (int it = gw; it < M * 4; it += NGW) {
        const int row = it >> 2, h = it & 3;
        const float2 o = *(const float2*)(oraw + (size_t)row * 512 + h * 128 + 2 * lane);
        const float r = rsqrtf(wave_sum(o.x * o.x + o.y * o.y) * (1.0f / 128.0f) + EPS);
        const unsigned gw2 = *(const unsigned*)(z + (size_t)row * ZP + C_HG + h * 128 + 2 * lane);
        *(unsigned*)(oa + (size_t)row * 512 + h * 128 + 2 * lane) = pk2(o.x * r * g0 * siluf(bflo(gw2)), o.y * r * g1 * siluf(bfhi(gw2)));
    }
}

__device__ __forceinline__ void s5_phase(const bf16* z, const Args& a, int l, bf16* ysg, int wave, int lane, int G) {
    if (wave != 0) return;
    const float* a_re = KIN(13) + l * 32 * 64; const float* a_im = KIN(14) + l * 32 * 64; const float* log_dt = KIN(15) + l * 32;
    const float* b_re = KIN(16) + l * 32 * 64 * 16; const float* b_im = KIN(17) + l * 32 * 64 * 16;
    const float* c_re = KIN(18) + l * 32 * 16 * 64; const float* c_im = KIN(19) + l * 32 * 16 * 64; const float* dsk = KIN(20) + l * 512;
    for (int unit = blockIdx.x; unit < 256; unit += G) {
        const int b = unit >> 5, g = unit & 31, n = lane;
        const float are = fminf(a_re[g * 64 + n], -1e-4f), aim = a_im[g * 64 + n], dt = expf(log_dt[g]);
        const float mag = expf(dt * are), abre = mag * cosf(dt * aim), abim = mag * sinf(dt * aim);
        const float den = are * are + aim * aim, nr = abre - 1.0f;
        const float zre = (nr * are + abim * aim) / den, zim = (abim * are - nr * aim) / den;
        float bbr[16], bbi[16], cr[16], ci[16], dl[16];
#pragma unroll
        for (int p = 0; p < 16; ++p) { const float br = b_re[(g * 64 + n) * 16 + p], bi = b_im[(g * 64 + n) * 16 + p];
            bbr[p] = zre * br - zim * bi; bbi[p] = zre * bi + zim * br; cr[p] = c_re[(g * 16 + p) * 64 + n]; ci[p] = c_im[(g * 16 + p) * 64 + n];
            dl[p] = (lane == 0) ? dsk[g * 16 + p] : 0.f; }
        float xr = 0.f, xi = 0.f;
        const bf16* zu = z + (size_t)(b * SEQ) * ZP + C_SU + g * 16;
        for (int t0 = 0; t0 < SEQ; t0 += 8) {
            u32x4 raw[8][2];
#pragma unroll
            for (int i = 0; i < 8; ++i) { raw[i][0] = *(const u32x4*)(zu + (size_t)(t0 + i) * ZP); raw[i][1] = *(const u32x4*)(zu + (size_t)(t0 + i) * ZP + 8); }
#pragma unroll
            for (int i = 0; i < 8; ++i) {
                float u[16];
#pragma unroll
                for (int hh = 0; hh < 2; ++hh) { u[hh * 8 + 0] = bflo(raw[i][hh].x); u[hh * 8 + 1] = bfhi(raw[i][hh].x); u[hh * 8 + 2] = bflo(raw[i][hh].y); u[hh * 8 + 3] = bfhi(raw[i][hh].y);
                    u[hh * 8 + 4] = bflo(raw[i][hh].z); u[hh * 8 + 5] = bfhi(raw[i][hh].z); u[hh * 8 + 6] = bflo(raw[i][hh].w); u[hh * 8 + 7] = bfhi(raw[i][hh].w); }
                float bur = 0.f, bui = 0.f;
#pragma unroll
                for (int p = 0; p < 16; ++p) { bur += bbr[p] * u[p]; bui += bbi[p] * u[p]; }
                const float nxr = abre * xr - abim * xi + bur, nxi = abre * xi + abim * xr + bui; xr = nxr; xi = nxi;
                float vals[16];
#pragma unroll
                for (int p = 0; p < 16; ++p) vals[p] = xr * cr[p] - xi * ci[p] + dl[p] * u[p];
#pragma unroll
                for (int i2 = 0; i2 < 8; ++i2) { const bool bt = (lane & 32) != 0; const float keep = bt ? vals[8 + i2] : vals[i2], send = bt ? vals[i2] : vals[8 + i2]; vals[i2] = keep + __shfl_xor(send, 32); }
#pragma unroll
                for (int i2 = 0; i2 < 4; ++i2) { const bool bt = (lane & 16) != 0; const float keep = bt ? vals[4 + i2] : vals[i2], send = bt ? vals[i2] : vals[4 + i2]; vals[i2] = keep + __shfl_xor(send, 16); }
#pragma unroll
                for (int i2 = 0; i2 < 2; ++i2) { const bool bt = (lane & 8) != 0; const float keep = bt ? vals[2 + i2] : vals[i2], send = bt ? vals[i2] : vals[2 + i2]; vals[i2] = keep + __shfl_xor(send, 8); }
                { const bool bt = (lane & 4) != 0; const float keep = bt ? vals[1] : vals[0], send = bt ? vals[0] : vals[1]; vals[0] = keep + __shfl_xor(send, 4); }
                float y = vals[0]; y += __shfl_xor(y, 2); y += __shfl_xor(y, 1);
                if ((lane & 3) == 0) ysg[(size_t)(b * SEQ + t0 + i) * 512 + g * 16 + (lane >> 2)] = (bf16)f2bf(gelu_tanh(y));
            }
        }
    }
}

__device__ __forceinline__ void s5_phase_nostore(const bf16* z, const Args& a, int l, bf16* ysg, int wave, int lane, int G) {
    if (wave != 0) return;
    const float* a_re = KIN(13) + l * 32 * 64; const float* a_im = KIN(14) + l * 32 * 64; const float* log_dt = KIN(15) + l * 32;
    const float* b_re = KIN(16) + l * 32 * 64 * 16; const float* b_im = KIN(17) + l * 32 * 64 * 16;
    const float* c_re = KIN(18) + l * 32 * 16 * 64; const float* c_im = KIN(19) + l * 32 * 16 * 64; const float* dsk = KIN(20) + l * 512;
    for (int unit = blockIdx.x; unit < 256; unit += G) {
        const int b = unit >> 5, g = unit & 31, n = lane;
        const float are = fminf(a_re[g * 64 + n], -1e-4f), aim = a_im[g * 64 + n], dt = expf(log_dt[g]);
        const float mag = expf(dt * are), abre = mag * cosf(dt * aim), abim = mag * sinf(dt * aim);
        const float den = are * are + aim * aim, nr = abre - 1.0f;
        const float zre = (nr * are + abim * aim) / den, zim = (abim * are - nr * aim) / den;
        float bbr[16], bbi[16], cr[16], ci[16], dl[16];
#pragma unroll
        for (int p = 0; p < 16; ++p) { const float br = b_re[(g * 64 + n) * 16 + p], bi = b_im[(g * 64 + n) * 16 + p];
            bbr[p] = zre * br - zim * bi; bbi[p] = zre * bi + zim * br; cr[p] = c_re[(g * 16 + p) * 64 + n]; ci[p] = c_im[(g * 16 + p) * 64 + n];
            dl[p] = (lane == 0) ? dsk[g * 16 + p] : 0.f; }
        float xr = 0.f, xi = 0.f;
        const bf16* zu = z + (size_t)(b * SEQ) * ZP + C_SU + g * 16;
        for (int t0 = 0; t0 < 8 * (int)(bbr[0] + bbi[3] + cr[5] + ci[7] + dl[2] == 123456.7f); t0 += 8) {
            u32x4 raw[8][2];
#pragma unroll
            for (int i = 0; i < 8; ++i) { raw[i][0] = *(const u32x4*)(zu + (size_t)(t0 + i) * ZP); raw[i][1] = *(const u32x4*)(zu + (size_t)(t0 + i) * ZP + 8); }
#pragma unroll
            for (int i = 0; i < 8; ++i) {
                float u[16];
#pragma unroll
                for (int hh = 0; hh < 2; ++hh) { u[hh * 8 + 0] = bflo(raw[i][hh].x); u[hh * 8 + 1] = bfhi(raw[i][hh].x); u[hh * 8 + 2] = bflo(raw[i][hh].y); u[hh * 8 + 3] = bfhi(raw[i][hh].y);
                    u[hh * 8 + 4] = bflo(raw[i][hh].z); u[hh * 8 + 5] = bfhi(raw[i][hh].z); u[hh * 8 + 6] = bflo(raw[i][hh].w); u[hh * 8 + 7] = bfhi(raw[i][hh].w); }
                float bur = 0.f, bui = 0.f;
#pragma unroll
                for (int p = 0; p < 16; ++p) { bur += bbr[p] * u[p]; bui += bbi[p] * u[p]; }
                const float nxr = abre * xr - abim * xi + bur, nxi = abre * xi + abim * xr + bui; xr = nxr; xi = nxi;
                float vals[16];
#pragma unroll
                for (int p = 0; p < 16; ++p) vals[p] = xr * cr[p] - xi * ci[p] + dl[p] * u[p];
#pragma unroll
                for (int i2 = 0; i2 < 8; ++i2) { const bool bt = (lane & 32) != 0; const float keep = bt ? vals[8 + i2] : vals[i2], send = bt ? vals[i2] : vals[8 + i2]; vals[i2] = keep + __shfl_xor(send, 32); }
#pragma unroll
                for (int i2 = 0; i2 < 4; ++i2) { const bool bt = (lane & 16) != 0; const float keep = bt ? vals[4 + i2] : vals[i2], send = bt ? vals[i2] : vals[4 + i2]; vals[i2] = keep + __shfl_xor(send, 16); }
#pragma unroll
                for (int i2 = 0; i2 < 2; ++i2) { const bool bt = (lane & 8) != 0; const float keep = bt ? vals[2 + i2] : vals[i2], send = bt ? vals[i2] : vals[2 + i2]; vals[i2] = keep + __shfl_xor(send, 8); }
                { const bool bt = (lane & 4) != 0; const float keep = bt ? vals[1] : vals[0], send = bt ? vals[0] : vals[1]; vals[0] = keep + __shfl_xor(send, 4); }
                float y = vals[0]; y += __shfl_xor(y, 2); y += __shfl_xor(y, 1);
                if ((lane & 3) == 0 && y == 123456.789f) ysg[(size_t)(b * SEQ + t0 + i) * 512 + g * 16 + (lane >> 2)] = (bf16)f2bf(gelu_tanh(y));
            }
        }
    }
}

typedef short bf16x8 __attribute__((ext_vector_type(8)));
typedef float f32x16 __attribute__((ext_vector_type(16)));
#define MFMA32(a, b, c) __builtin_amdgcn_mfma_f32_32x32x16_bf16((a), (b), (c), 0, 0, 0)
constexpr float LOG2E = 1.4426950408889634f;
constexpr int TPITCH = 144;
constexpr int TILEB = 64 * TPITCH;
__device__ __forceinline__ int crow(int r, int hi) { return (r & 3) + 8 * (r >> 2) + 4 * hi; }
__device__ __forceinline__ int vpos(int k) { return (k & ~12) | ((k & 4) << 1) | ((k & 8) >> 1); }

__device__ __forceinline__ void norm64_inplace(bf16* p, const float* gain, float mult) {
    u32x4 w[8]; float ss = 0.f;
#pragma unroll
    for (int k = 0; k < 8; ++k) { w[k] = ((const u32x4*)p)[k];
        const float a0 = bflo(w[k].x), a1 = bfhi(w[k].x), a2 = bflo(w[k].y), a3 = bfhi(w[k].y), a4 = bflo(w[k].z), a5 = bfhi(w[k].z), a6 = bflo(w[k].w), a7 = bfhi(w[k].w);
        ss += (a0 * a0 + a1 * a1) + (a2 * a2 + a3 * a3) + (a4 * a4 + a5 * a5) + (a6 * a6 + a7 * a7); }
    const float r = rsqrtf(ss * (1.0f / 64.0f) + EPS) * mult;
#pragma unroll
    for (int k = 0; k < 8; ++k) { const f32x4 g0 = *(const f32x4*)(gain + 8 * k), g1 = *(const f32x4*)(gain + 8 * k + 4);
        u32x4 o; o.x = pk2(bflo(w[k].x) * r * g0[0], bfhi(w[k].x) * r * g0[1]); o.y = pk2(bflo(w[k].y) * r * g0[2], bfhi(w[k].y) * r * g0[3]);
        o.z = pk2(bflo(w[k].z) * r * g1[0], bfhi(w[k].z) * r * g1[1]); o.w = pk2(bflo(w[k].w) * r * g1[2], bfhi(w[k].w) * r * g1[3]);
        ((u32x4*)p)[k] = o; }
}
__device__ __forceinline__ void nsa_prep2_phase(bf16* z, const float* qg, const float* kg, bf16* vst, bf16* vwt, LAS unsigned char* lds, int tid, int u0, int ustride) {
    __syncthreads();
    for (int unit = u0; unit < 256; unit += ustride) {
        const int b = unit >> 5, tb = unit & 31; const size_t row0 = (size_t)b * SEQ + tb * 64;
        { const int tok = tid >> 3, ch = tid & 7, pc = vpos(tok);
#pragma unroll
          for (int ti = 0; ti < 8; ++ti) { const int g = ti & 3, col = ((ti >> 2) ? C_VW : C_VS) + g * 64 + ch * 8;
              const u32x4 w = *(const u32x4*)(z + (row0 + tok) * ZP + col);
              LAS unsigned short* T = (LAS unsigned short*)(lds + ti * TILEB) + pc;
              T[(ch * 8 + 0) * 72] = (unsigned short)(w.x & 0xffffu); T[(ch * 8 + 1) * 72] = (unsigned short)(w.x >> 16);
              T[(ch * 8 + 2) * 72] = (unsigned short)(w.y & 0xffffu); T[(ch * 8 + 3) * 72] = (unsigned short)(w.y >> 16);
              T[(ch * 8 + 4) * 72] = (unsigned short)(w.z & 0xffffu); T[(ch * 8 + 5) * 72] = (unsigned short)(w.z >> 16);
              T[(ch * 8 + 6) * 72] = (unsigned short)(w.w & 0xffffu); T[(ch * 8 + 7) * 72] = (unsigned short)(w.w >> 16); } }
#pragma unroll 1
        for (int v = tid; v < 1024; v += 512) { const int tok = v >> 4, hd = v & 15; norm64_inplace(z + (row0 + tok) * ZP + C_NQ + hd * 64, qg, 0.125f * LOG2E); }
        { const int tok = tid >> 3, wh = (tid >> 2) & 1, g = tid & 3; norm64_inplace(z + (row0 + tok) * ZP + (wh ? C_KW : C_KS) + g * 64, kg, 1.0f); }
        __syncthreads();
        { const int d = tid >> 3, ch = tid & 7;
#pragma unroll
          for (int ti = 0; ti < 8; ++ti) { const int g = ti & 3; bf16* dst = (ti >> 2) ? vwt : vst;
              const u32x4 w = *(const LAS u32x4*)(lds + ti * TILEB + d * TPITCH + ch * 16);
              *(u32x4*)(dst + ((size_t)(b * 4 + g) * 64 + d) * SEQ + tb * 64 + ch * 8) = w; } }
        __syncthreads();
    }
}

__device__ __forceinline__ void nsa_compress2_phase(const bf16* z, const float* pek, const float* pev, const float* phik, const float* phiv, const float* kg,
                                                    bf16* kch, bf16* kcl, bf16* vct, int gw, int NGW, int lane) {
    const float kgl = kg[lane];
    for (int unit = gw; unit < BATCH * 128 * 4; unit += NGW) {
        const int g = unit & 3, n = (unit >> 2) & 127, b = unit >> 9;
        const size_t ko = ((size_t)(b * 4 + g) * 128 + n) * 64 + lane, vo = ((size_t)(b * 4 + g) * 64 + lane) * 128 + vpos(n);
        if (n == NCMP) { kch[ko] = 0; kcl[ko] = 0; vct[vo] = 0; continue; }
        const bf16* zk = z + (size_t)(b * SEQ + 16 * n) * ZP + C_KC + g * 64 + lane;
        const bf16* zv = z + (size_t)(b * SEQ + 16 * n) * ZP + C_VC + g * 64 + lane;
        float ak = 0.f, av = 0.f;
        for (int l = 0; l < 32; ++l) {
            const float kval = bf2f(zk[(size_t)l * ZP]) + pek[l * 64 + lane], vval = bf2f(zv[(size_t)l * ZP]) + pev[l * 64 + lane];
            const float* pk = phik + (size_t)l * 4096 + lane; const float* pv = phiv + (size_t)l * 4096 + lane;
#pragma unroll 16
            for (int d = 0; d < 64; ++d) { ak += __shfl(kval, d) * pk[d * 64]; av += __shfl(vval, d) * pv[d * 64]; }
        }
        const float ss = wave_sum(ak * ak);
        const float kn = ak * rsqrtf(ss * (1.0f / 64.0f) + EPS) * kgl;
        const unsigned h = f2bf(kn); const float hf = __uint_as_float(h << 16);
        kch[ko] = (bf16)h; kcl[ko] = (bf16)f2bf(kn - hf); vct[vo] = (bf16)f2bf(av);
    }
}

__device__ __forceinline__ void prologue_phi(bf16* phit, float* pec, int tid, int gtid, int NGT) {
    for (int ch = gtid; ch < 4 * 64 * 256; ch += NGT) { const int which = ch >> 14, e = (ch >> 8) & 63, kc = ch & 255;
        const float* phi = KIN(26 + (which & 1)) + (size_t)(which >> 1) * 131072 + (size_t)kc * 8 * 64 + e; float v[8];
#pragma unroll
        for (int i = 0; i < 8; ++i) v[i] = phi[i * 64];
        u32x4 o; o.x = pk2(v[0], v[1]); o.y = pk2(v[2], v[3]); o.z = pk2(v[4], v[5]); o.w = pk2(v[6], v[7]);
        *(u32x4*)(phit + ((size_t)which * 64 + e) * 2048 + kc * 8) = o; }
    if (blockIdx.x == 2 % gridDim.x && tid < 256) { const int which = tid >> 6, e = tid & 63;
        const float* phi = KIN(26 + (which & 1)) + (size_t)(which >> 1) * 131072 + e; const float* pe = KIN(24 + (which & 1)) + (size_t)(which >> 1) * 2048; float sacc = 0.f;
        for (int k = 0; k < 2048; ++k) sacc += pe[k] * phi[(size_t)k * 64];
        pec[which * 64 + e] = sacc; }
}
__device__ __forceinline__ void nsa_compress3_phase(const bf16* z, const bf16* phit, const float* pec, const float* kg, bf16* kch, bf16* kcl, bf16* vct, LAS unsigned char* lds, int tid, int u0, int ustride) {
    LAS float* part = (LAS float*)lds;
    const int lane = tid & 63, wave = __builtin_amdgcn_readfirstlane(tid >> 6), r32 = lane & 31, hi = lane >> 5;
    __syncthreads();
    for (int unit = u0; unit < 256; unit += ustride) {
        const int mt = unit & 3, kv = (unit >> 2) & 1, g = (unit >> 3) & 3, b = unit >> 5;
        int n = 32 * mt + r32; n = n > NCMP - 1 ? NCMP - 1 : n;
        const bf16* ap = z + ((size_t)b * SEQ + 16 * n) * ZP + (kv ? C_VC : C_KC) + g * 64 + 8 * hi;
        const bf16* bp = phit + (size_t)kv * 64 * 2048 + (size_t)r32 * 2048 + 8 * hi;
        f32x16 acc0, acc1;
#pragma unroll
        for (int r = 0; r < 16; ++r) { acc0[r] = 0.f; acc1[r] = 0.f; }
#pragma unroll 4
        for (int st = 0; st < 16; ++st) { const int sidx = wave * 16 + st, l = sidx >> 2, d0 = (sidx & 3) * 16;
            const bf16x8 af = *(const bf16x8*)(ap + (size_t)l * ZP + d0);
            const bf16x8 b0 = *(const bf16x8*)(bp + 16 * sidx), b1 = *(const bf16x8*)(bp + 32 * 2048 + 16 * sidx);
            acc0 = MFMA32(af, b0, acc0); acc1 = MFMA32(af, b1, acc1); }
#pragma unroll
        for (int r = 0; r < 16; ++r) { part[(wave * 32 + crow(r, hi)) * 64 + r32] = acc0[r]; part[(wave * 32 + crow(r, hi)) * 64 + 32 + r32] = acc1[r]; }
        __syncthreads();
        { const int row = tid >> 4, e0 = (tid & 15) * 4; f32x4 v = *(const f32x4*)(pec + kv * 64 + e0);
#pragma unroll
          for (int w = 0; w < 8; ++w) v += *(const LAS f32x4*)(part + (w * 32 + row) * 64 + e0);
          const int nn = 32 * mt + row; const size_t bg = (size_t)(b * 4 + g);
          if (kv == 0) {
              float ss = (v[0] * v[0] + v[1] * v[1]) + (v[2] * v[2] + v[3] * v[3]);
              ss += __shfl_xor(ss, 1); ss += __shfl_xor(ss, 2); ss += __shfl_xor(ss, 4); ss += __shfl_xor(ss, 8);
              const float rs = rsqrtf(ss * (1.0f / 64.0f) + EPS); const f32x4 gn = *(const f32x4*)(kg + e0);
              unsigned hw[4]; float lo[4];
#pragma unroll
              for (int j = 0; j < 4; ++j) { const float kn = (nn < NCMP) ? v[j] * rs * gn[j] : 0.f; hw[j] = f2bf(kn); lo[j] = kn - __uint_as_float(hw[j] << 16); }
              u32x2 oh, ol; oh.x = hw[0] | (hw[1] << 16); oh.y = hw[2] | (hw[3] << 16); ol.x = pk2(lo[0], lo[1]); ol.y = pk2(lo[2], lo[3]);
              *(u32x2*)(kch + (bg * 128 + nn) * 64 + e0) = oh; *(u32x2*)(kcl + (bg * 128 + nn) * 64 + e0) = ol;
          } else {
#pragma unroll
              for (int j = 0; j < 4; ++j) vct[(bg * 64 + e0 + j) * 128 + vpos(nn)] = (bf16)f2bf((nn < NCMP) ? v[j] : 0.f);
          } }
        __syncthreads();
    }
}

__device__ __forceinline__ void ng_phase(const bf16* u, const bf16* wt, bf16* z, LAS unsigned char* lds, int tid, int G) {
    const int lane = tid & 63, wave = __builtin_amdgcn_readfirstlane(tid >> 6), r32 = lane & 31, hi = lane >> 5, kq = wave & 3, rbl = wave >> 2;
    constexpr int NIB = 96, NPASS = (M / 64 + NIB - 1) / NIB;
    __syncthreads();
#pragma unroll 1
    for (int pass = 0; pass < NPASS; ++pass) {
        int bx_ = (int)blockIdx.x; asm volatile("" : "+s"(bx_));
        const int d_ = bx_ - 128; const bool isrec = d_ >= 0 && (d_ & 3) == 0;
        const int ib = d_ - (d_ >> 2) - 1;
        const int rb = 2 * (ib + NIB * pass) + rbl;
        const bool act = d_ >= 0 && !isrec && (ib + NIB * pass) < M / 64 && G == 256;
        if (act) {
            const bf16* ap = u + (size_t)(32 * rb + r32) * D + kq * 512 + 8 * hi;
            const bf16* b0p = wt + (size_t)r32 * D + kq * 512 + 8 * hi;
            const bf16* b1p = wt + (size_t)(32 + (r32 & 15)) * D + kq * 512 + 8 * hi;
            f32x16 acc0, acc1;
#pragma unroll
            for (int r = 0; r < 16; ++r) { acc0[r] = 0.f; acc1[r] = 0.f; }
#pragma unroll 8
            for (int s = 0; s < 32; ++s) {
                const bf16x8 av = *(const bf16x8*)(ap + 16 * s), b0 = *(const bf16x8*)(b0p + 16 * s), b1 = *(const bf16x8*)(b1p + 16 * s);
                acc0 = MFMA32(b0, av, acc0); acc1 = MFMA32(b1, av, acc1);
            }
            LAS float* P = (LAS float*)lds + ((rbl * 4 + kq) * 2) * 1024 + lane * 16;
#pragma unroll
            for (int a = 0; a < 4; ++a) { *(LAS f32x4*)(P + 4 * a) = (f32x4){acc0[4 * a], acc0[4 * a + 1], acc0[4 * a + 2], acc0[4 * a + 3]};
                                          *(LAS f32x4*)(P + 1024 + 4 * a) = (f32x4){acc1[4 * a], acc1[4 * a + 1], acc1[4 * a + 2], acc1[4 * a + 3]}; }
        }
        __syncthreads();
        if (act && kq == 0) {
            const LAS float* Q = (const LAS float*)lds + (rbl * 4 * 2) * 1024 + lane * 16;
            bf16* op = z + (size_t)(32 * rb + r32) * ZP + C_NG + 4 * hi;
#pragma unroll
            for (int cb = 0; cb < 2; ++cb)
#pragma unroll
                for (int a = 0; a < 4; ++a) { if (cb == 1 && a >= 2) continue;
                    f32x4 t = *(const LAS f32x4*)(Q + cb * 1024 + 4 * a);
#pragma unroll
                    for (int q = 1; q < 4; ++q) { const f32x4 t2 = *(const LAS f32x4*)(Q + (q * 2 + cb) * 1024 + 4 * a); t[0] += t2[0]; t[1] += t2[1]; t[2] += t2[2]; t[3] += t2[3]; }
                    u32x2 w; w.x = pk2(t[0], t[1]); w.y = pk2(t[2], t[3]);
                    *(u32x2*)(op + 32 * cb + 8 * a) = w; }
        }
        __syncthreads();
    }
}

__device__ __forceinline__ void qk_tile(f32x16& s0, f32x16& s1, const LAS unsigned char* Kt, const bf16x8 (&qf)[4], int r32, int hi) {
#pragma unroll
    for (int d0 = 0; d0 < 4; ++d0) {
        const bf16x8 k0 = *(const LAS bf16x8*)(Kt + r32 * TPITCH + (16 * d0 + 8 * hi) * 2);
        const bf16x8 k1 = *(const LAS bf16x8*)(Kt + (r32 + 32) * TPITCH + (16 * d0 + 8 * hi) * 2);
        s0 = MFMA32(k0, qf[d0], s0); s1 = MFMA32(k1, qf[d0], s1);
    }
}
__device__ __forceinline__ bf16x8 pack8(const f32x16& p, int j) {
    u32x4 w; w.x = cvt_pk_bf16(p[8 * j + 0], p[8 * j + 1]); w.y = cvt_pk_bf16(p[8 * j + 2], p[8 * j + 3]); w.z = cvt_pk_bf16(p[8 * j + 4], p[8 * j + 5]); w.w = cvt_pk_bf16(p[8 * j + 6], p[8 * j + 7]);
    return __builtin_bit_cast(bf16x8, w);
}
__device__ __forceinline__ void pv_tile(f32x16 (&o)[2], const LAS unsigned char* Vt, const f32x16& p0, const f32x16& p1, int r32, int hi) {
#pragma unroll
    for (int j = 0; j < 2; ++j) { const bf16x8 pw = pack8(p0, j);
#pragma unroll
        for (int db = 0; db < 2; ++db) { const bf16x8 vf = *(const LAS bf16x8*)(Vt + (r32 + 32 * db) * TPITCH + (16 * j + 8 * hi) * 2); o[db] = MFMA32(vf, pw, o[db]); } }
#pragma unroll
    for (int j = 0; j < 2; ++j) { const bf16x8 pw = pack8(p1, j);
#pragma unroll
        for (int db = 0; db < 2; ++db) { const bf16x8 vf = *(const LAS bf16x8*)(Vt + (r32 + 32 * db) * TPITCH + (32 + 16 * j + 8 * hi) * 2); o[db] = MFMA32(vf, pw, o[db]); } }
}
__device__ __forceinline__ float max16(const f32x16& a, const f32x16& b) {
    float m = fmaxf(a[0], b[0]);
#pragma unroll
    for (int r = 1; r < 16; ++r) m = fmaxf(m, fmaxf(a[r], b[r]));
    return m;
}
__device__ __forceinline__ void softmax_pv(f32x16& s0, f32x16& s1, float& mrun, float& lsum, f32x16 (&o)[2], const LAS unsigned char* Vt, int r32, int hi, float boff, bool dead) {
    float mt = max16(s0, s1); mt = fmaxf(mt, __shfl_xor(mt, 32)); mt = dead ? -INFINITY : mt + boff;
    const float mnew = fmaxf(mrun, mt), msafe = (mnew == -INFINITY) ? 0.f : mnew;
    const float alpha = __builtin_amdgcn_exp2f(mrun - msafe);
    typedef float f32x2v __attribute__((ext_vector_type(2)));
    const float msub = dead ? INFINITY : msafe - boff;
    const f32x2v mm = {msub, msub}; f32x2v ps2 = {0.f, 0.f};
#pragma unroll
    for (int r = 0; r < 16; r += 2) {
        f32x2v d0 = (f32x2v){s0[r], s0[r + 1]} - mm, d1 = (f32x2v){s1[r], s1[r + 1]} - mm;
        s0[r] = __builtin_amdgcn_exp2f(d0[0]); s0[r + 1] = __builtin_amdgcn_exp2f(d0[1]); s1[r] = __builtin_amdgcn_exp2f(d1[0]); s1[r + 1] = __builtin_amdgcn_exp2f(d1[1]);
        ps2 += (f32x2v){s0[r], s0[r + 1]}; ps2 += (f32x2v){s1[r], s1[r + 1]}; }
    lsum = lsum * alpha + (ps2[0] + ps2[1]); mrun = mnew;
#pragma unroll
    for (int r = 0; r < 16; ++r) { o[0][r] *= alpha; o[1][r] *= alpha; }
    pv_tile(o, Vt, s0, s1, r32, hi);
}
__device__ __forceinline__ u32x4 tile_ld(const bf16* g, size_t gp, int tid) { return *(const u32x4*)(g + (size_t)(tid >> 3) * gp + (tid & 7) * 8); }
__device__ __forceinline__ void tile_st(LAS unsigned char* t, const u32x4 w, int tid) { *(LAS u32x4*)(t + (tid >> 3) * TPITCH + (tid & 7) * 16) = w; }

template <int MODE>
__device__ __forceinline__ void attn_branch(const bf16* kbase, const bf16* vtbase, int jlo, int jhi, int qb, unsigned selmask, int iq_in, const bf16x8 (&qf)[4], const LAS float* biasW,
                                            LAS unsigned char* tb, f32x16 (&o)[2], float& mrun, float& lsum, int tid_in, int r32, int hi_in) {
    int tid = tid_in; asm volatile("" : "+v"(tid));
    { const u32x4 kw = tile_ld(kbase + (size_t)jlo * 64 * ZP, ZP, tid), vw = tile_ld(vtbase + jlo * 64, SEQ, tid); tile_st(tb, kw, tid); tile_st(tb + TILEB, vw, tid); }
    __syncthreads();
    const float b31 = biasW[64 + 127];
    for (int j = jlo; j <= jhi; ++j) {
        const int cur = (j - jlo) & 1; const bool more = j < jhi;
        LAS unsigned char* Kt = tb + cur * 2 * TILEB; LAS unsigned char* Vt = Kt + TILEB;
        u32x4 kw, vw;
        if (more) { kw = tile_ld(kbase + (size_t)(j + 1) * 64 * ZP, ZP, tid); vw = tile_ld(vtbase + (j + 1) * 64, SEQ, tid); }
        int hi = hi_in, iq = iq_in; asm volatile("" : "+v"(hi), "+v"(iq));
        f32x16 s0, s1; const int dj = qb - j;
        const bool sel = (MODE == 0) ? (((selmask >> j) & 1u) != 0u) : true;
        if (dj >= 3) {
#pragma unroll
            for (int r = 0; r < 16; ++r) { s0[r] = 0.f; s1[r] = 0.f; }
        } else {
            const int e0 = 64 * dj + iq + 64;
#pragma unroll
            for (int r = 0; r < 16; ++r) { const int kl = crow(r, hi); s0[r] = biasW[e0 - kl]; s1[r] = biasW[e0 - kl - 32]; }
        }
        qk_tile(s0, s1, Kt, qf, r32, hi);
        if (MODE == 0 && dj < 3) { if (!sel) {
#pragma unroll
            for (int r = 0; r < 16; ++r) { s0[r] = -INFINITY; s1[r] = -INFINITY; } } }
        if (dj == 0) {
#pragma unroll
            for (int r = 0; r < 16; ++r) { const int kl = crow(r, hi); if (kl > iq) s0[r] = -INFINITY; if (kl + 32 > iq) s1[r] = -INFINITY; }
        }
        if (MODE == 1 && dj == 8) {
#pragma unroll
            for (int r = 0; r < 16; ++r) { const int kl = crow(r, hi); if (kl <= iq) s0[r] = -INFINITY; if (kl + 32 <= iq) s1[r] = -INFINITY; }
        }
        softmax_pv(s0, s1, mrun, lsum, o, Vt, r32, hi, dj >= 3 ? b31 : 0.f, dj >= 3 && !sel);
        if (more) { LAS unsigned char* Kn = tb + (cur ^ 1) * 2 * TILEB; tile_st(Kn, kw, tid); tile_st(Kn + TILEB, vw, tid); }
        __syncthreads();
    }
}

constexpr int AT_TILES = 0, AT_BIAS = 6 * TILEB, AT_IMP = AT_BIAS + 16 * 256 * 4, AT_MASK = AT_IMP + 4 * 64 * 33 * 4, AT_INVL = AT_MASK + 64 * 4, AT_END = AT_INVL + 4 * 64 * 4;
static_assert(AT_END <= RING_BYTES, "attention LDS map");

__device__ __forceinline__ void nsa_mfma_phase(const bf16* z, const bf16* kch, const bf16* kcl, const bf16* vct, const bf16* vst, const bf16* vwt, const float* biasTab, bf16* oc,
                                               LAS unsigned char* lds, int tid0, int vcu, int G) {
    const int tid = tid0; const int lane = tid & 63, wave = __builtin_amdgcn_readfirstlane(tid >> 6), r32_p = lane & 31, hi_p = lane >> 5, hh = wave & 3, ts = wave >> 2;
    LAS unsigned char* tb = lds + AT_TILES; LAS float* biasL = (LAS float*)(lds + AT_BIAS); LAS float* impH = (LAS float*)(lds + AT_IMP); LAS unsigned* maskS = (LAS unsigned*)(lds + AT_MASK); LAS float* invlS = (LAS float*)(lds + AT_INVL);
    __syncthreads();
    for (int i = tid; i < 16 * 256; i += 512) { const int head = i >> 8, d = (i & 255) - 64; const int dc = d < 0 ? 0 : (d > 127 ? 127 : d); biasL[i] = biasTab[dc * 16 + head] * LOG2E; }
    __syncthreads();
    for (int p0 = vcu; p0 < 512; p0 += G) {
#pragma unroll 1
      for (int half = 0; half < 2; ++half) {
        const int bg = p0 >> 4, b = bg >> 2, g = bg & 3, qb = half ? 31 - (p0 & 15) : (p0 & 15);
        int r32 = r32_p; asm volatile("" : "+v"(r32));
        const int iq = 32 * ts + r32, t = 64 * qb + iq, head = g * 4 + hh; const size_t row = (size_t)b * SEQ + t;
        const LAS float* biasW = biasL + head * 256;
        bf16x8 qf[4];
#pragma unroll
        for (int d0 = 0; d0 < 4; ++d0) qf[d0] = *(const bf16x8*)(z + row * ZP + C_NQ + head * 64 + d0 * 16 + hi_p * 8);
        f32x16 tot[2];
#pragma unroll
        for (int r = 0; r < 16; ++r) { tot[0][r] = 0.f; tot[1][r] = 0.f; }
        unsigned selmask = (qb <= 15) ? ((2u << qb) - 1u) : 0u;
        {
            const int ntile = (qb >= 16) ? 2 : 1;
            const bf16* kh = kch + (size_t)(b * 4 + g) * 128 * 64; const bf16* kl_ = kcl + (size_t)(b * 4 + g) * 128 * 64; const bf16* vt = vct + (size_t)(b * 4 + g) * 64 * 128;
            int tid = tid0; asm volatile("" : "+v"(tid));
            for (int ti = 0; ti < ntile; ++ti) { tile_st(tb + ti * TILEB, tile_ld(kh + ti * 64 * 64, 64, tid), tid); tile_st(tb + (2 + ti) * TILEB, tile_ld(kl_ + ti * 64 * 64, 64, tid), tid);
                tile_st(tb + (4 + ti) * TILEB, tile_ld(vt + ti * 64, 128, tid), tid); }
            for (int i = tid; i < 64; i += 512) maskS[i] = 0u;
            __syncthreads();
            const int nmaxl = (t - 31) >> 4;
            float m = -INFINITY;
#pragma unroll 1
            for (int ti = 0; ti < ntile; ++ti) {
                int hi = hi_p; asm volatile("" : "+v"(hi));
                f32x16 s0, s1;
#pragma unroll
                for (int r = 0; r < 16; ++r) { const int n0 = 64 * ti + crow(r, hi); int d0_ = t - 16 * n0 - 31, d1_ = d0_ - 512;
                    d0_ = d0_ < 0 ? 0 : (d0_ > 127 ? 127 : d0_); d1_ = d1_ < 0 ? 0 : (d1_ > 127 ? 127 : d1_);
                    s0[r] = biasW[64 + d0_]; s1[r] = biasW[64 + d1_]; }
                qk_tile(s0, s1, tb + ti * TILEB, qf, r32, hi);
                qk_tile(s0, s1, tb + (2 + ti) * TILEB, qf, r32, hi);
#pragma unroll
                for (int r = 0; r < 16; ++r) { const int n0 = 64 * ti + crow(r, hi); if (n0 > nmaxl) s0[r] = -INFINITY; if (n0 + 32 > nmaxl) s1[r] = -INFINITY; }
                m = fmaxf(m, max16(s0, s1));
            }
            m = fmaxf(m, __shfl_xor(m, 32));
            const float msafe = (m == -INFINITY) ? 0.f : m; float l = 0.f, prev_pc = 0.f;
#pragma unroll 1
            for (int ti = 0; ti < ntile; ++ti) {
                int hi = hi_p; asm volatile("" : "+v"(hi));
                f32x16 s0, s1;
#pragma unroll
                for (int r = 0; r < 16; ++r) { const int n0 = 64 * ti + crow(r, hi); int d0_ = t - 16 * n0 - 31, d1_ = d0_ - 512;
                    d0_ = d0_ < 0 ? 0 : (d0_ > 127 ? 127 : d0_); d1_ = d1_ < 0 ? 0 : (d1_ > 127 ? 127 : d1_);
                    s0[r] = biasW[64 + d0_]; s1[r] = biasW[64 + d1_]; }
                qk_tile(s0, s1, tb + ti * TILEB, qf, r32, hi);
                qk_tile(s0, s1, tb + (2 + ti) * TILEB, qf, r32, hi);
#pragma unroll
                for (int r = 0; r < 16; ++r) { const int n0 = 64 * ti + crow(r, hi); if (n0 > nmaxl) s0[r] = -INFINITY; if (n0 + 32 > nmaxl) s1[r] = -INFINITY; }
#pragma unroll
                for (int r = 0; r < 16; ++r) { s0[r] = __builtin_amdgcn_exp2f(s0[r] - msafe); s1[r] = __builtin_amdgcn_exp2f(s1[r] - msafe); l += s0[r] + s1[r]; }
                pv_tile(tot, tb + (4 + ti) * TILEB, s0, s1, r32, hi);
                if (qb >= 16) {
#pragma unroll
                    for (int sb = 0; sb < 2; ++sb)
#pragma unroll
                        for (int a = 0; a < 4; ++a) { const int Gi = 8 * ti + 4 * sb + a; const f32x16& sx = sb ? s1 : s0;
                            const float bs = (sx[4 * a] + sx[4 * a + 1]) + (sx[4 * a + 2] + sx[4 * a + 3]);
                            const float pcv = __shfl_xor(sx[4 * a + 3], 32);
                            const float cin = hi ? pcv : prev_pc; prev_pc = pcv;
                            impH[(hh * 64 + iq) * 33 + 2 * Gi + hi] = bs + cin; }
                }
            }
            l += __shfl_xor(l, 32);
            const float invl = l > 0.f ? 1.0f / l : 0.f;
            { const float g0 = sigm(bf2f(z[row * ZP + C_NG + head])) * invl;
#pragma unroll
              for (int r = 0; r < 16; ++r) { tot[0][r] *= g0; tot[1][r] *= g0; } }
            if (qb >= 16) {
                if (hi_p == 0) invlS[hh * 64 + iq] = invl;
                __syncthreads();
                { const int tok = tid >> 3, jg = tid & 7; unsigned bits = 0u; const LAS float* i0 = impH + tok * 33;
                  const float w0 = invlS[tok], w1 = invlS[64 + tok], w2 = invlS[128 + tok], w3 = invlS[192 + tok];
#pragma unroll 1
                  for (int jj = 0; jj < 4; ++jj) { const int j = jg * 4 + jj; if (j < 1 || j > qb - 2) continue;
                      const float x = (i0[j] * w0 + i0[64 * 33 + j] * w1) + (i0[2 * 64 * 33 + j] * w2 + i0[3 * 64 * 33 + j] * w3); int cnt = 0;
                      for (int j2 = 1; j2 <= qb - 2; ++j2) { const float y = (i0[j2] * w0 + i0[64 * 33 + j2] * w1) + (i0[2 * 64 * 33 + j2] * w2 + i0[3 * 64 * 33 + j2] * w3); cnt += (y > x || (y == x && j2 < j)) ? 1 : 0; }
                      if (cnt < 13) bits |= 1u << j; }
                  if (bits) __hip_atomic_fetch_or(maskS + tok, bits, __ATOMIC_RELAXED, __HIP_MEMORY_SCOPE_WORKGROUP); }
                __syncthreads();
                selmask = maskS[iq] | 1u | (1u << qb) | (1u << (qb - 1));
            }
            __syncthreads();
        }
        {
            f32x16 o[2]; float mrun = -INFINITY, lsum = 0.f;
#pragma unroll
            for (int r = 0; r < 16; ++r) { o[0][r] = 0.f; o[1][r] = 0.f; }
            attn_branch<0>(z + (size_t)b * SEQ * ZP + C_KS + g * 64, vst + (size_t)(b * 4 + g) * 64 * SEQ, 0, qb, qb, selmask, iq, qf, biasW, tb, o, mrun, lsum, tid, r32, hi_p);
            lsum += __shfl_xor(lsum, 32);
            const float g1 = sigm(bf2f(z[row * ZP + C_NG + 16 + head])) / lsum;
#pragma unroll
            for (int r = 0; r < 16; ++r) { tot[0][r] += o[0][r] * g1; tot[1][r] += o[1][r] * g1; }
        }
        {
            f32x16 o[2]; float mrun = -INFINITY, lsum = 0.f;
#pragma unroll
            for (int r = 0; r < 16; ++r) { o[0][r] = 0.f; o[1][r] = 0.f; }
            attn_branch<1>(z + (size_t)b * SEQ * ZP + C_KW + g * 64, vwt + (size_t)(b * 4 + g) * 64 * SEQ, qb >= 8 ? qb - 8 : 0, qb, qb, 0u, iq, qf, biasW, tb, o, mrun, lsum, tid, r32, hi_p);
            lsum += __shfl_xor(lsum, 32);
            const float g2 = sigm(bf2f(z[row * ZP + C_NG + 32 + head])) / lsum;
#pragma unroll
            for (int r = 0; r < 16; ++r) { tot[0][r] += o[0][r] * g2; tot[1][r] += o[1][r] * g2; }
        }
        { bf16* op = oc + row * 1024 + head * 64;
#pragma unroll
          for (int db = 0; db < 2; ++db)
#pragma unroll
              for (int a = 0; a < 4; ++a) { u32x2 w; w.x = pk2(tot[db][4 * a], tot[db][4 * a + 1]); w.y = pk2(tot[db][4 * a + 2], tot[db][4 * a + 3]);
                  *(u32x2*)(op + 32 * db + 8 * a + 4 * hi_p) = w; } }
      }
    }
}

constexpr size_t HG_ARR = (size_t)32 * 64 * 32 * 128;
__device__ __forceinline__ void hgrn_prep_phase(const bf16* z, const float* lbv, bf16* hq, float* dd, int tid, int G) {
    bf16* QT = hq; bf16* KT = hq + HG_ARR; bf16* KHT = hq + 2 * HG_ARR; bf16* IT = hq + 3 * HG_ARR;
    const int w_ = tid >> 6, role = w_ >> 2, sub = w_ & 3, ln = tid & 63;
    for (int u0 = blockIdx.x * 4; u0 < 2048; u0 += G * 4) {
        const int u = u0 + sub, bh = u >> 6, c = u & 63, b = bh >> 2, h = bh & 3;
        const size_t row0 = (size_t)b * SEQ + 32 * c; const size_t tile = ((size_t)bh * 64 + c) * 4096;
        if (role == 0) { const int k = 2 * ln; const float lb0 = lbv[h * 128 + k], lb1 = lbv[h * 128 + k + 1], om0 = 1.0f - lb0, om1 = 1.0f - lb1; float bc0 = 0.f, bc1 = 0.f; float kk0[32], kk1[32], bv0[32], bv1[32];
            const bf16* zq = z + row0 * ZP + C_HQ + h * 128 + k; const bf16* zf = z + row0 * ZP + C_HF + h * 128 + k; const int kp = vpos(k);
#pragma unroll
            for (int tau = 0; tau < 32; ++tau) { const unsigned q2 = *(const unsigned*)(zq + (size_t)tau * ZP), f2 = *(const unsigned*)(zf + (size_t)tau * ZP);
                const float xf0 = fminf(fmaxf(bflo(f2), -30.f), 30.f), xf1 = fminf(fmaxf(bfhi(f2), -30.f), 30.f);
                const float e0 = __expf(-xf0), r0 = __builtin_amdgcn_rcpf(1.0f + e0), e1 = __expf(-xf1), r1 = __builtin_amdgcn_rcpf(1.0f + e1);
                const float f0 = lb0 + om0 * r0, f1 = lb1 + om1 * r1, k0v = om0 * (e0 * r0), k1v = om1 * (e1 * r1);
                bc0 += __logf(f0); bc1 += __logf(f1); kk0[tau] = k0v; kk1[tau] = k1v; bv0[tau] = bc0; bv1[tau] = bc1;
                *(unsigned*)(QT + tile + tau * 128 + kp) = pk2(siluf(bflo(q2)) * __expf(bc0), siluf(bfhi(q2)) * __expf(bc1));
                *(unsigned*)(KT + tile + tau * 128 + kp) = pk2(k0v * __expf(-bc0), k1v * __expf(-bc1)); }
            *(float2*)(dd + ((size_t)bh * 64 + c) * 128 + k) = make_float2(__expf(bc0), __expf(bc1));
#pragma unroll
            for (int g4 = 0; g4 < 4; ++g4) { float v[8]; u32x4 o;
#pragma unroll
                for (int i = 0; i < 8; ++i) v[i] = kk0[8 * g4 + i] * __expf(bc0 - bv0[8 * g4 + i]);
                o.x = pk2(v[0], v[1]); o.y = pk2(v[2], v[3]); o.z = pk2(v[4], v[5]); o.w = pk2(v[6], v[7]); *(u32x4*)(KHT + tile + k * 32 + 8 * g4) = o;
#pragma unroll
                for (int i = 0; i < 8; ++i) v[i] = kk1[8 * g4 + i] * __expf(bc1 - bv1[8 * g4 + i]);
                o.x = pk2(v[0], v[1]); o.y = pk2(v[2], v[3]); o.z = pk2(v[4], v[5]); o.w = pk2(v[6], v[7]); *(u32x4*)(KHT + tile + (k + 1) * 32 + 8 * g4) = o; }
        } else { const int v = 2 * ln; const bf16* zi = z + row0 * ZP + C_HI + h * 128 + v; unsigned w[32];
#pragma unroll
            for (int sg = 0; sg < 32; ++sg) w[sg] = *(const unsigned*)(zi + (size_t)sg * ZP);
#pragma unroll
            for (int g4 = 0; g4 < 4; ++g4) { u32x4 o;
                o.x = (w[8 * g4] & 0xffffu) | (w[8 * g4 + 1] << 16); o.y = (w[8 * g4 + 2] & 0xffffu) | (w[8 * g4 + 3] << 16); o.z = (w[8 * g4 + 4] & 0xffffu) | (w[8 * g4 + 5] << 16); o.w = (w[8 * g4 + 6] & 0xffffu) | (w[8 * g4 + 7] << 16);
                *(u32x4*)(IT + tile + v * 32 + 8 * g4) = o;
                o.x = (w[8 * g4] >> 16) | (w[8 * g4 + 1] & 0xffff0000u); o.y = (w[8 * g4 + 2] >> 16) | (w[8 * g4 + 3] & 0xffff0000u); o.z = (w[8 * g4 + 4] >> 16) | (w[8 * g4 + 5] & 0xffff0000u); o.w = (w[8 * g4 + 6] >> 16) | (w[8 * g4 + 7] & 0xffff0000u);
                *(u32x4*)(IT + tile + (v + 1) * 32 + 8 * g4) = o; }
        }
    }
}
constexpr int HP_Q = 272, HP_K = 80;
constexpr int HB_QT = 0, HB_KT = 32 * HP_Q, HB_HG = 2 * 32 * HP_Q, HB_KHT = 3 * 32 * HP_Q, HB_IT = HB_KHT + 128 * HP_K, HB_DD = HB_IT + 128 * HP_K, HB_SIZE = HB_DD + 512;
constexpr int HB_NX = 2 * HB_SIZE;
static_assert(HB_NX + 512 <= RING_BYTES && (HB_SIZE % 16) == 0, "hgrn LDS map");
__device__ __forceinline__ bf16x8 pack8s(const f32x16& p, int j) {
    u32x4 w; w.x = cvt_pk_bf16(p[8 * j + 0], p[8 * j + 1]); w.y = cvt_pk_bf16(p[8 * j + 2], p[8 * j + 3]); w.z = cvt_pk_bf16(p[8 * j + 4], p[8 * j + 5]); w.w = cvt_pk_bf16(p[8 * j + 6], p[8 * j + 7]);
    return __builtin_bit_cast(bf16x8, w);
}
__device__ __forceinline__ void hgrn_rec_phase(const bf16* z, const bf16* hq, const float* dd, float* oraw, LAS unsigned char* lds, int tid0, int G) {
    const bf16* QT = hq; const bf16* KT = hq + HG_ARR; const bf16* KHT = hq + 2 * HG_ARR; const bf16* IT = hq + 3 * HG_ARR;
    LAS float* nx = (LAS float*)(lds + HB_NX);
    __syncthreads();
    { const int act0 = ((int)blockIdx.x >= 128 && (((int)blockIdx.x - 128) & 3) == 0) ? 1 : 0; const int bh = act0 ? (((int)blockIdx.x - 128) >> 2) : 0;
#define HG_ACT() ({ int a_ = __builtin_amdgcn_readfirstlane(act0); asm volatile("" : "+s"(a_)); a_ != 0; })
        int tid = tid0; asm volatile("" : "+v"(tid));
        const int lane = tid & 63, wave = __builtin_amdgcn_readfirstlane(tid >> 6), r32 = lane & 31, hi = lane >> 5, b = bh >> 2, h = bh & 3;
        const int vq = wave & 3;
        const int q_row = tid >> 4, q_c16 = tid & 15, k_row = tid >> 2, k_c = tid & 3;
        u32x4 sQ, sK, sH, sI, sD, tQ, tK, tH, tI, tD;
#define HG_LOAD(c_, rQ, rK, rH, rI, rD) do { const size_t tl_ = ((size_t)bh * 64 + (c_)) * 4096; \
            rQ = *(const u32x4*)(QT + tl_ + q_row * 128 + q_c16 * 8); rK = *(const u32x4*)(KT + tl_ + q_row * 128 + q_c16 * 8); \
            rH = *(const u32x4*)(KHT + tl_ + k_row * 32 + k_c * 8); rI = *(const u32x4*)(IT + tl_ + k_row * 32 + k_c * 8); \
            if (tid < 32) rD = *(const u32x4*)(dd + ((size_t)bh * 64 + (c_)) * 128 + tid * 4); } while (0)
#define HG_STORE(buf_) do { LAS unsigned char* B_ = lds + (buf_) * HB_SIZE; \
            *(LAS u32x4*)(B_ + HB_QT + q_row * HP_Q + q_c16 * 16) = sQ; *(LAS u32x4*)(B_ + HB_KT + q_row * HP_Q + q_c16 * 16) = sK; \
            *(LAS u32x4*)(B_ + HB_KHT + k_row * HP_K + k_c * 16) = sH; *(LAS u32x4*)(B_ + HB_IT + k_row * HP_K + k_c * 16) = sI; \
            if (tid < 32) *(LAS u32x4*)(B_ + HB_DD + tid * 16) = sD; } while (0)
        f32x16 S[4];
#pragma unroll
        for (int kb = 0; kb < 4; ++kb)
#pragma unroll
            for (int r = 0; r < 16; ++r) S[kb][r] = 0.f;
        if (HG_ACT()) { HG_LOAD(0, sQ, sK, sH, sI, sD); HG_STORE(0); HG_LOAD(1, sQ, sK, sH, sI, sD); }
        __syncthreads();
#pragma unroll 1
        for (int c = 0; c < 64; ++c) {
            const bool act = HG_ACT(); const bool comp = act && wave < 4;
            if (act && c + 2 < 64) HG_LOAD(c + 2, tQ, tK, tH, tI, tD);
            const LAS unsigned char* B = lds + (c & 1) * HB_SIZE;
            f32x16 oT;
            if (comp) {
                f32x16 at, at2, oT2;
#pragma unroll
                for (int r = 0; r < 16; ++r) { at[r] = 0.f; at2[r] = 0.f; oT[r] = 0.f; oT2[r] = 0.f; }
#pragma unroll
                for (int s = 0; s < 8; s += 2) {
                    const bf16x8 q0 = *(const LAS bf16x8*)(B + HB_QT + r32 * HP_Q + (16 * s + 8 * hi) * 2), q1 = *(const LAS bf16x8*)(B + HB_QT + r32 * HP_Q + (16 * s + 16 + 8 * hi) * 2);
                    const bf16x8 kf = *(const LAS bf16x8*)(B + HB_KT + r32 * HP_Q + (16 * s + 8 * hi) * 2), kf2 = *(const LAS bf16x8*)(B + HB_KT + r32 * HP_Q + (16 * s + 16 + 8 * hi) * 2);
                    at = MFMA32(kf, q0, at); at2 = MFMA32(kf2, q1, at2);
                    oT = MFMA32(pack8s(S[s >> 1], 0), q0, oT); oT2 = MFMA32(pack8s(S[s >> 1], 1), q1, oT2); }
#pragma unroll
                for (int r = 0; r < 16; ++r) { at[r] = (crow(r, hi) > r32) ? 0.f : at[r] + at2[r]; oT[r] += oT2[r]; }
                const LAS unsigned char* itr = B + HB_IT + (32 * vq + r32) * HP_K;
#pragma unroll
                for (int j = 0; j < 2; ++j) { const u32x2 i0 = *(const LAS u32x2*)(itr + (16 * j + 4 * hi) * 2), i1 = *(const LAS u32x2*)(itr + (16 * j + 8 + 4 * hi) * 2);
                    u32x4 iw; iw.x = i0.x; iw.y = i0.y; iw.z = i1.x; iw.w = i1.y; oT = MFMA32(__builtin_bit_cast(bf16x8, iw), pack8s(at, j), oT); }
#pragma unroll
                for (int kb = 0; kb < 4; ++kb) {
#pragma unroll
                    for (int a = 0; a < 4; ++a) { const f32x4 d4 = *(const LAS f32x4*)(B + HB_DD + (32 * kb + 8 * a + 4 * hi) * 4);
                        S[kb][4 * a] *= d4[0]; S[kb][4 * a + 1] *= d4[1]; S[kb][4 * a + 2] *= d4[2]; S[kb][4 * a + 3] *= d4[3]; }
#pragma unroll
                    for (int j = 0; j < 2; ++j) { const bf16x8 khf = *(const LAS bf16x8*)(B + HB_KHT + (32 * kb + r32) * HP_K + (16 * j + 8 * hi) * 2);
                        const bf16x8 itf = *(const LAS bf16x8*)(itr + (16 * j + 8 * hi) * 2); S[kb] = MFMA32(khf, itf, S[kb]); } }
                float* op = oraw + ((size_t)b * SEQ + 32 * c + r32) * 512 + h * 128 + 32 * vq;
#pragma unroll
                for (int a = 0; a < 4; ++a) *(f32x4*)(op + 8 * a + 4 * hi) = (f32x4){oT[4 * a], oT[4 * a + 1], oT[4 * a + 2], oT[4 * a + 3]};
            }
            if (act && c + 1 < 64) HG_STORE((c + 1) & 1);
            sQ = tQ; sK = tK; sH = tH; sI = tI; sD = tD;
            __syncthreads();
        }
#undef HG_LOAD
#undef HG_STORE
    }
}

constexpr int S5K = 640;
__device__ __forceinline__ void s5_build_phase(bf16* BT0, bf16* WT0, float* AL0, LAS unsigned char* lds, int tid, int G) {
    const int unit_ = (int)blockIdx.x; const bool active = unit_ < 256 && G >= 256; const int l = active ? (unit_ >> 7) : 0, pq = unit_ & 3;
    bf16* BT = BT0 + (size_t)l * (S5BT_L / 2); bf16* WT = WT0 + (size_t)l * (S5WT_L / 2); float* AL = AL0 + (size_t)l * (S5AL_L / 4);
    LAS float* Pt = (LAS float*)lds;
    LAS float* Kt = Pt + 33 * 128;
    LAS float* Bb = Kt + 32 * 256;
    LAS float* Cc = Bb + 64 * 32;
    const float* a_re = KIN(13) + l * 32 * 64; const float* a_im = KIN(14) + l * 32 * 64; const float* log_dt = KIN(15) + l * 32;
    const float* b_re = KIN(16) + l * 32 * 64 * 16; const float* b_im = KIN(17) + l * 32 * 64 * 16;
    const float* c_re = KIN(18) + l * 32 * 16 * 64; const float* c_im = KIN(19) + l * 32 * 16 * 64;
    __syncthreads();
    { const int g = (unit_ >> 2) & 31;
        if (active && tid < 64) { const int n = tid;
            const float are = fminf(a_re[g * 64 + n], -1e-4f), aim = a_im[g * 64 + n], dt = expf(log_dt[g]);
            const float mag = expf(dt * are), abre = mag * cosf(dt * aim), abim = mag * sinf(dt * aim);
            const float den = are * are + aim * aim, nr = abre - 1.0f;
            const float zre = (nr * are + abim * aim) / den, zim = (abim * are - nr * aim) / den;
            for (int p = 0; p < 16; ++p) { const float br = b_re[(g * 64 + n) * 16 + p], bi = b_im[(g * 64 + n) * 16 + p];
                Bb[(n * 16 + p) * 2] = zre * br - zim * bi; Bb[(n * 16 + p) * 2 + 1] = zre * bi + zim * br;
                Cc[(p * 64 + n) * 2] = c_re[(g * 16 + p) * 64 + n]; Cc[(p * 64 + n) * 2 + 1] = c_im[(g * 16 + p) * 64 + n]; }
        }
        for (int e = active ? tid : 33 * 64; e < 33 * 64; e += 512) { const int k = e >> 6, n = e & 63;
            const float are = fminf(a_re[g * 64 + n], -1e-4f), aim = a_im[g * 64 + n], dt = expf(log_dt[g]);
            const float mk = expf((float)k * dt * are), ang = (float)k * dt * aim; Pt[(k * 64 + n) * 2] = mk * cosf(ang); Pt[(k * 64 + n) * 2 + 1] = mk * sinf(ang); }
        __syncthreads();
        if (active && pq == 0 && tid < 64) { const int n = tid; AL[(g * 64 + n) * 2] = Pt[(32 * 64 + n) * 2]; AL[(g * 64 + n) * 2 + 1] = Pt[(32 * 64 + n) * 2 + 1]; }
        for (int e0 = active ? tid : 32 * 64; e0 < 32 * 64; e0 += 512) { const int dl = e0 >> 6, p = 4 * pq + ((e0 >> 4) & 3), pp = e0 & 15; float s = 0.f;
            for (int n = 0; n < 64; ++n) { const float cr = Cc[(p * 64 + n) * 2], ci = Cc[(p * 64 + n) * 2 + 1], pr = Pt[(dl * 64 + n) * 2], pi = Pt[(dl * 64 + n) * 2 + 1];
                const float xr = cr * pr - ci * pi, xi = cr * pi + ci * pr; s += xr * Bb[(n * 16 + pp) * 2] - xi * Bb[(n * 16 + pp) * 2 + 1]; }
            Kt[(dl * 16 + p) * 16 + pp] = s; }
        __syncthreads();
        for (int ch0 = active ? tid : 128 * 80; ch0 < 128 * 80; ch0 += 512) { const int r4 = ch0 / 80, cc = ch0 - r4 * 80, tau = r4 >> 2, p = 4 * pq + (r4 & 3), row = tau * 16 + p; float v[8];
            if (cc < 64) { const int sg = cc >> 1, pp0 = (cc & 1) * 8;
#pragma unroll
                for (int i = 0; i < 8; ++i) v[i] = (sg <= tau) ? Kt[((tau - sg) * 16 + p) * 16 + pp0 + i] : 0.f;
            } else { const int n0 = (cc - 64) * 4;
#pragma unroll
                for (int i = 0; i < 4; ++i) { const int n = n0 + i; const float cr = Cc[(p * 64 + n) * 2], ci = Cc[(p * 64 + n) * 2 + 1], pr = Pt[((tau + 1) * 64 + n) * 2], pi = Pt[((tau + 1) * 64 + n) * 2 + 1];
                    v[2 * i] = cr * pr - ci * pi; v[2 * i + 1] = -(cr * pi + ci * pr); } }
            u32x4 o; o.x = pk2(v[0], v[1]); o.y = pk2(v[2], v[3]); o.z = pk2(v[4], v[5]); o.w = pk2(v[6], v[7]);
            *(u32x4*)(BT + ((size_t)g * 512 + row) * S5K + cc * 8) = o; }
        for (int ch0 = active ? tid : 32 * 64; ch0 < 32 * 64; ch0 += 512) { const int col = 32 * pq + (ch0 >> 6), kc = ch0 & 63, n = col >> 1, ri = col & 1, sg = kc >> 1, pp0 = (kc & 1) * 8; float v[8];
            const float pr = Pt[((31 - sg) * 64 + n) * 2], pi = Pt[((31 - sg) * 64 + n) * 2 + 1];
#pragma unroll
            for (int i = 0; i < 8; ++i) { const float br = Bb[(n * 16 + pp0 + i) * 2], bi = Bb[(n * 16 + pp0 + i) * 2 + 1]; v[i] = ri ? (pr * bi + pi * br) : (pr * br - pi * bi); }
            u32x4 o; o.x = pk2(v[0], v[1]); o.y = pk2(v[2], v[3]); o.z = pk2(v[4], v[5]); o.w = pk2(v[6], v[7]);
            *(u32x4*)(WT + ((size_t)g * 128 + col) * 512 + kc * 8) = o; }
        __syncthreads();
    }
}
__device__ __forceinline__ void s5_state_phase(const bf16* z, const bf16* WT, const float* AL, bf16* AEXT, LAS unsigned char* lds, int tid, int G) {
    LAS float* Sl = (LAS float*)lds;
    const int lane = tid & 63, wave = __builtin_amdgcn_readfirstlane(tid >> 6), r32 = lane & 31, hi = lane >> 5, mi = wave >> 2, ni = wave & 3;
    __syncthreads();
    for (int unit = blockIdx.x; unit < 256; unit += G) {
        const int b = unit >> 5, g = unit & 31;
        const int c = 32 * mi + r32;
        const bf16* ap = z + ((size_t)b * SEQ + 32 * c) * ZP + C_SU + g * 16 + 8 * hi;
        const bf16* bp = WT + ((size_t)g * 128 + 32 * ni + r32) * 512 + 8 * hi;
        bf16* ae = AEXT + ((size_t)g * 512 + b * 64 + c) * S5K + 8 * hi;
        f32x16 acc;
#pragma unroll
        for (int r = 0; r < 16; ++r) acc[r] = 0.f;
#pragma unroll 8
        for (int sg = 0; sg < 32; ++sg) {
            const bf16x8 af = *(const bf16x8*)(ap + (size_t)sg * ZP); const bf16x8 bfr = *(const bf16x8*)(bp + 16 * sg);
            acc = MFMA32(af, bfr, acc);
            if (ni == 0) *(bf16x8*)(ae + 16 * sg) = af;
        }
#pragma unroll
        for (int r = 0; r < 16; ++r) Sl[(32 * mi + crow(r, hi)) * 132 + 32 * ni + r32] = acc[r];
        __syncthreads();
        if (tid < 64) { const int n = tid; const float alr = AL[(g * 64 + n) * 2], ali = AL[(g * 64 + n) * 2 + 1]; float xr = 0.f, xi = 0.f;
            unsigned* xo = (unsigned*)(AEXT + ((size_t)g * 512 + b * 64) * S5K + 512 + 2 * n);
            for (int cc = 0; cc < 64; ++cc) { xo[(size_t)cc * (S5K / 2)] = pk2(xr, xi);
                const float sr = Sl[cc * 132 + 2 * n], si = Sl[cc * 132 + 2 * n + 1];
                const float nxr = alr * xr - ali * xi + sr, nxi = alr * xi + ali * xr + si; xr = nxr; xi = nxi; } }
        __syncthreads();
    }
}
struct S5Order {
    int G, c;
    __device__ __forceinline__ bool next(int i, Unit& u) const { const int L = i * G + c; if (L >= 128) return false; const int g = L >> 2; u.pm = 2 * g + ((L >> 1) & 1); u.pn = 2 * g + (L & 1); return true; }
    __device__ __forceinline__ void a_ready(const Unit&) const {}
    __device__ __forceinline__ void done(const Unit&) const {}
};
struct EpiS5 {
    static constexpr bool PERM = false, AFTER_DRAIN = false;
    const bf16* z; const float* dsk; bf16* ysg;
    __device__ __forceinline__ void operator()(const f32x4 (&acc)[2][2][4][2], const Unit& u, int wr, int wc, int fr, int fq) const {
        const int g = u.pm >> 1, mh = u.pm & 1, nh = u.pn & 1;
#pragma unroll
        for (int ai = 0; ai < 2; ++ai)
#pragma unroll
            for (int m = 0; m < 4; ++m) { const int rowg = mh * 256 + ai * 128 + wr * 64 + m * 16 + fr, b = rowg >> 6, c = rowg & 63;
#pragma unroll
                for (int bj = 0; bj < 2; ++bj)
#pragma unroll
                    for (int n = 0; n < 2; ++n) { const int colg = nh * 256 + bj * 128 + wc * 32 + n * 16 + 4 * fq, tau = colg >> 4, ch = g * 16 + (colg & 15);
                        const size_t tok = (size_t)b * SEQ + 32 * c + tau;
                        const u32x2 uw = *(const u32x2*)(z + tok * ZP + C_SU + ch); const f32x4 d4 = *(const f32x4*)(dsk + ch); const f32x4 a = acc[ai][bj][m][n];
                        u32x2 o; o.x = pk2(gelu_tanh(a[0] + d4[0] * bflo(uw.x)), gelu_tanh(a[1] + d4[1] * bfhi(uw.x))); o.y = pk2(gelu_tanh(a[2] + d4[2] * bflo(uw.y)), gelu_tanh(a[3] + d4[3] * bfhi(uw.y)));
                        *(u32x2*)(ysg + tok * 512 + ch) = o; } }
    }
};

#ifndef REP_HGRN
#define REP_HGRN 1
#endif
#ifndef REP_S5
#define REP_S5 1
#endif
#ifndef REP_CMP
#define REP_CMP 1
#endif
#ifndef REP_ATTN
#define REP_ATTN 1
#endif
#define GEMM_PHASE(EPI, Aptr, Btptr, Nn, Kk, Eobj) do { pg8::Gemm g_{(const pg8::bf16_t*)(Aptr), (const pg8::bf16_t*)(Btptr), M, (Nn), (Kk)}; pg8::StaticOrder S_; S_.init(M, (Nn), G, (int)blockIdx.x); \
        pg8::gemm_phase<EPI, pg8::StaticOrder, true, true>(lds, g_, S_, (Eobj)); } while (0)

__global__ void __launch_bounds__(NWAVES * 64, 2) fwd_kernel(Args a) {
    extern __shared__ __attribute__((aligned(16))) unsigned char lds_raw[];
    LAS unsigned char* lds = (LAS unsigned char*)lds_raw;
    const int G = gridDim.x; const int bx = blockIdx.x;
    const int vcu = (G % 8 == 0) ? (bx % 8) * (G / 8) + bx / 8 : bx;
    const int NGW = G * NWAVES;
#define IDS() int tid = threadIdx.x; asm volatile("" : "+v"(tid)); const int lane = tid & 63, wave = __builtin_amdgcn_readfirstlane(tid >> 6), gw = vcu * NWAVES + wave; (void)lane; (void)wave; (void)gw
    for (int u = threadIdx.x; u < (LDS_BYTES - RING_BYTES) / 4; u += NWAVES * 64) ((LAS unsigned*)(lds + RING_BYTES))[u] = 0u;
    __syncthreads();
    unsigned char* ws = KWS();
    (void)xcd_barrier_post((unsigned*)(ws + WS_CTL) + CW_BAR, (volatile LAS unsigned*)(lds + MISC_OFF));
#define GRID_BAR() do { XcdBarrier b_; b_.bar = (unsigned*)(KWS() + WS_CTL) + CW_BAR; b_.x = xb_xcc_id(); b_.st = (volatile LAS unsigned*)(lds + MISC_OFF); xcd_barrier(b_); } while (0)

    float* mod = (float*)(ws + WS_MOD);
    float* biasTab = (float*)(ws + WS_SMALL); float* lbv = biasTab + 128 * 16;
    bf16* KCH = (bf16*)(ws + WS_KCH); bf16* KCL = (bf16*)(ws + WS_KCL); bf16* VCT = (bf16*)(ws + WS_VCT); bf16* VST = (bf16*)(ws + WS_VST); bf16* VWT = (bf16*)(ws + WS_VWT);
    bf16* U = (bf16*)(ws + WS_U); bf16* ACT = (bf16*)(ws + WS_ACT); bf16* Z = (bf16*)(ws + WS_Z);
    bf16* S5BT = (bf16*)(ws + WS_S5BT); bf16* S5AE = (bf16*)(ws + WS_S5AE); bf16* S5WT = (bf16*)(ws + WS_S5WT); float* S5AL = (float*)(ws + WS_S5AL);
    float* ORAW = (float*)(ws + WS_ORAW); bf16* OA = (bf16*)(ws + WS_OA); bf16* YSG = (bf16*)(ws + WS_YSG); bf16* OC = (bf16*)(ws + WS_OC);
    float* hout = KOUT();

    { IDS(); prologue_small(a, tid); }
    { IDS(); prologue_phi((bf16*)(KWS() + WS_PHIT), (float*)(KWS() + WS_PEC), tid, (int)blockIdx.x * 512 + tid, G * 512); }
#ifndef NO_MOD
    { IDS(); prologue_mod(a, lds, tid, G); }
#endif
    __syncthreads();
    for (int l = 0; l < DEPTH; ++l) {
    { IDS(); prologue_transposes(l, lds, gw, NGW, wave, lane); }
    }
    { IDS(); s5_build_phase(S5BT, S5WT, S5AL, lds, tid, G); }
    GRID_BAR();

#pragma unroll 1
    for (int l = 0; l < DEPTH; ++l) {
        const unsigned char* wl = ws + WS_W + (size_t)l * LAYER_W;
        const float* modl = mod + (size_t)l * 8 * MODW;
        const float* ng = KIN(4) + (size_t)l * 3 * D;
        const float* hin = (l == 0) ? KIN(0) : hout;
    { IDS(); norm_phase(hin, ng, modl + 0 * D, modl + 1 * D, U, gw, NGW, lane); }
        GRID_BAR();
        { EpiSwiGLU E{ACT, DFF}; GEMM_PHASE(EpiSwiGLU, U, wl + W_WI1, 2 * DFF, D, E); }
        GRID_BAR();
        { EpiResid E{hin, hout, modl + 2 * D, 0.5f}; GEMM_PHASE(EpiResid, ACT, wl + W_WO1, D, DFF, E); }
        GRID_BAR();
    { IDS(); norm_phase(hout, ng + D, modl + 3 * D, modl + 4 * D, U, gw, NGW, lane); }
        GRID_BAR();
        { EpiStoreBf16 E{Z, ZP}; GEMM_PHASE(EpiStoreBf16, U, wl + W_WIN, C_NG, D, E); }
        GRID_BAR();
#ifndef NO_HGRN
    { IDS(); hgrn_prep_phase(Z, lbv + l * 512, ACT, (float*)(KWS() + WS_HGDD), tid, G); }
#endif
#ifndef NO_S5
    for (int rep_ = 0; rep_ < REP_S5; ++rep_){ IDS(); s5_state_phase(Z, S5WT + (size_t)l * (S5WT_L / 2), S5AL + (size_t)l * (S5AL_L / 4), S5AE, lds, tid, G); }
#endif
        GRID_BAR();
    { IDS(); ng_phase(U, (const bf16*)(wl + W_WIN) + (size_t)C_NG * D, Z, lds, tid, G); }
    { IDS(); nsa_prep2_phase(Z, KIN(22) + l * 64, KIN(23) + l * 64, VST, VWT, lds, tid, (int)blockIdx.x < 128 ? (int)blockIdx.x : 256, 128); }
    for (int rep_ = 0; rep_ < REP_CMP; ++rep_){ IDS(); nsa_compress3_phase(Z, (const bf16*)(KWS() + WS_PHIT) + (size_t)l * 2 * 64 * 2048, (const float*)(KWS() + WS_PEC) + l * 128, KIN(23) + l * 64, KCH, KCL, VCT, lds, tid, (int)blockIdx.x < 128 ? (int)blockIdx.x : 256, 128); }
        { EpiS5 E{Z, KIN(20) + l * 512, YSG}; pg8::Gemm g_{(const pg8::bf16_t*)S5AE, (const pg8::bf16_t*)(S5BT + (size_t)l * (S5BT_L / 2)), M, M, S5K}; S5Order S_{G, (int)blockIdx.x};
          pg8::gemm_phase<EpiS5, S5Order, true, true>(lds, g_, S_, E); }
        __syncthreads();
    { IDS(); hgrn_rec_phase(Z, ACT, (const float*)(KWS() + WS_HGDD), ORAW, lds, tid, G); }
        GRID_BAR();
    { IDS(); hgrn_post_phase(ORAW, Z, KIN(11) + l * 128, OA, gw, NGW, lane); }
#ifndef NO_ATTN
    for (int rep_ = 0; rep_ < REP_ATTN; ++rep_){ IDS(); nsa_mfma_phase(Z, KCH, KCL, VCT, VST, VWT, biasTab, OC, lds, tid, vcu, G); }
#endif
        GRID_BAR();
        { EpiMergeB E{Z + C_ZB, U}; GEMM_PHASE(EpiMergeB, YSG, wl + W_GLU, 4096, 512, E); }
        GRID_BAR();
        { EpiMergeAcc E{Z + C_ZA, U}; GEMM_PHASE(EpiMergeAcc, OA, wl + W_HGP, D, 512, E); }
        { EpiMergeAcc E{Z + C_ZC, U}; GEMM_PHASE(EpiMergeAcc, OC, wl + W_NSP, D, 1024, E); }
        GRID_BAR();
        { EpiResid E{hout, hout, modl + 5 * D, 1.0f}; GEMM_PHASE(EpiResid, U, wl + W_WOUT, D, D, E); }
        GRID_BAR();
    { IDS(); norm_phase(hout, ng + 2 * D, modl + 6 * D, modl + 7 * D, U, gw, NGW, lane); }
        GRID_BAR();
        { EpiSwiGLU E{ACT, DFF}; GEMM_PHASE(EpiSwiGLU, U, wl + W_WI2, 2 * DFF, D, E); }
        GRID_BAR();
        { EpiResid E{hout, hout, modl + 8 * D, 0.5f}; GEMM_PHASE(EpiResid, ACT, wl + W_WO2, D, DFF, E); }
        GRID_BAR();
    }
}

extern "C" void kernel_launch(void* const* d_in, const int* in_sizes, int n_in, void* d_out, int out_size, void* d_ws, size_t ws_size, hipStream_t stream) {
    static int grid = 0;
    if (grid == 0) {
        if (n_in != 31 || out_size != M * D || ws_size < WS_END) { fprintf(stderr, "kernel_launch: unexpected problem (n_in %d, out %d, ws %zu, need %zu)\n", n_in, out_size, ws_size, (size_t)WS_END); grid = -1; return; }
        int dev = 0, cus = 0, per_cu = 0;
        if (hipGetDevice(&dev) != hipSuccess || hipDeviceGetAttribute(&cus, hipDeviceAttributeMultiprocessorCount, dev) != hipSuccess) { grid = -1; return; }
        if (hipFuncSetAttribute((const void*)fwd_kernel, hipFuncAttributeMaxDynamicSharedMemorySize, LDS_BYTES) != hipSuccess) { fprintf(stderr, "kernel_launch: hipFuncSetAttribute failed\n"); grid = -1; return; }
        if (hipOccupancyMaxActiveBlocksPerMultiprocessor(&per_cu, (const void*)fwd_kernel, NWAVES * 64, LDS_BYTES) != hipSuccess || per_cu < 1) fprintf(stderr, "kernel_launch: occupancy query says %d\n", per_cu);
        (void)hipGetLastError();
        grid = cus;
    }
    if (grid < 0) return;
    if (hipMemsetAsync((char*)d_ws + WS_CTL, 0, CTL_ZERO_BYTES, stream) != hipSuccess) return;
    Args a{};
    for (int i = 0; i < 31; ++i) a.in[i] = (const float*)d_in[i];
    a.out = (float*)d_out; a.ws = (unsigned char*)d_ws;
    hipLaunchKernelGGL(fwd_kernel, dim3(grid), dim3(NWAVES * 64), LDS_BYTES, stream, a);
    (void)in_sizes;
}
```

```cpp
#include <hip/hip_runtime.h>
#include <cstdio>
#include <cstdint>
namespace pg8 {
#define PG8_LAS __attribute__((address_space(3)))
typedef unsigned short bf16_t;
typedef short bf16x8 __attribute__((ext_vector_type(8)));
typedef float f32x4 __attribute__((ext_vector_type(4)));
typedef unsigned u32x4 __attribute__((ext_vector_type(4)));
constexpr int BM = 256, BK = 64, HALF = 128, HTB = HALF * BK * 2  , STAGE_BYTES = 8 * HTB, NXCD = 8, WGM = 8;

__host__ __device__ __forceinline__ int lds_byte(int r, int c) { const int st = (r >> 4) * 2 + (c >> 5), rr = r & 15, cc = c & 31, ob = rr * 64 + cc * 2; return st * 1024 + (ob ^ (((ob >> 9) & 1) << 5)); }
__host__ __device__ __forceinline__ void stage_rc(int b, int& R, int& C) { const int st = b / 1024, sb = b % 1024, swz = sb ^ (((sb >> 9) & 1) << 5); R = (st >> 1) * 16 + swz / 64; C = (st & 1) * 32 + (swz % 64) / 2; }
__host__ __device__ __forceinline__ int perm32(int rho) { const int n = rho >> 4, i = rho & 15; return 8 * (i >> 2) + 4 * n + (i & 3); }

struct Unit { int pm, pn; };
struct Gemm { const bf16_t* A; const bf16_t* Bt; int M, N, K; };

struct StaticOrder {
    int nM, nN, nwg, G, c;
    __host__ __device__ void init(int M, int N, int G_, int c_) { nM = M / BM; nN = N / BM; nwg = nM * nN; G = G_; c = c_; }
    __host__ __device__ bool next(int i, Unit& u) const {
        const long L = (long)i * G + c; if (L >= nwg) return false;
        int wgid = (int)L; { const int q = nwg / NXCD, r = nwg % NXCD, xcd = wgid % NXCD, off = wgid / NXCD; wgid = (xcd < r ? xcd * (q + 1) : r * (q + 1) + (xcd - r) * q) + off; }
        const int nig = WGM * nN, gid = wgid / nig, fm = gid * WGM, gsz = (nM - fm) < WGM ? (nM - fm) : WGM;
        u.pm = fm + ((wgid % nig) % gsz); u.pn = (wgid % nig) / gsz; return true;
    }
    __device__ __forceinline__ void a_ready(const Unit&) const {}
    __device__ __forceinline__ void done(const Unit&) const {}
};
typedef float pg8_f32x2_t __attribute__((ext_vector_type(2)));
typedef __bf16 pg8_bf16x2_t __attribute__((ext_vector_type(2)));
__device__ __forceinline__ unsigned cvt_pk_bf16(float lo, float hi) { const pg8_f32x2_t v = {lo, hi}; return __builtin_bit_cast(unsigned, __builtin_convertvector(v, pg8_bf16x2_t)); }
typedef float f32x2 __attribute__((ext_vector_type(2)));
template <class Epi, class Sched, bool ALIGN_EPI = false, bool SP2 = false>
__device__ __forceinline__ void gemm_phase(PG8_LAS unsigned char* lds, const Gemm g, const Sched& S, const Epi& E) {
    int tid_ = threadIdx.x; asm volatile("" : "+v"(tid_));
    const int tid = tid_, wid = __builtin_amdgcn_readfirstlane(tid >> 6), lane = tid & 63, wr = wid >> 2, wc = wid & 3, fr = lane & 15, fq = lane >> 4;
    const int K = g.K, nt = K / BK;
    unsigned voffA[2], voffB[2];
#pragma unroll
    for (int i = 0; i < 2; ++i) { int R, C; stage_rc(tid * 16 + i * 8192, R, C); const int Rb = Epi::PERM ? ((R & ~31) + perm32(R & 31)) : R;
        voffA[i] = (unsigned)(R * K + C) * 2u; voffB[i] = (unsigned)(Rb * K + C) * 2u; }
    const size_t kstep = (size_t)(BK * 2);
    const size_t hstep = (size_t)HALF * K * 2;
    const size_t tstep = 2 * hstep;
    const unsigned ldsw = (unsigned)wid * 1024u;
    const int aoff = lds_byte(wr * 64 + fr, fq * 8), boff = lds_byte(wc * 32 + fr, fq * 8);
#define PG8_SA(b, h) (((b) * 2 + (h)) * HTB)
#define PG8_SB(b, h) ((4 + (b) * 2 + (h)) * HTB)
#define PG8_STAGE(bufoff, gbase, voff) do { _Pragma("unroll") for (int _i = 0; _i < 2; ++_i) \
        __builtin_amdgcn_global_load_lds((const unsigned*)((const char*)(gbase) + (voff)[_i]), (PG8_LAS unsigned*)(lds + (bufoff) + ldsw + _i * 8192), 16, 0, 0); } while (0)
#define PG8_LDA(dst, b, h) do { _Pragma("unroll") for (int m = 0; m < 4; ++m) _Pragma("unroll") for (int k = 0; k < 2; ++k) dst[m][k] = *(const PG8_LAS bf16x8*)(lds + PG8_SA(b, h) + aoff + m * 2048 + k * 1024); } while (0)
#define PG8_LDB(dst, b, h) do { _Pragma("unroll") for (int n = 0; n < 2; ++n) _Pragma("unroll") for (int k = 0; k < 2; ++k) dst[n][k] = *(const PG8_LAS bf16x8*)(lds + PG8_SB(b, h) + boff + n * 2048 + k * 1024); } while (0)
#define PG8_MMA(ai, bj, At, Bt) do { __builtin_amdgcn_s_setprio(1); _Pragma("unroll") for (int m = 0; m < 4; ++m) _Pragma("unroll") for (int n = 0; n < 2; ++n) _Pragma("unroll") for (int k = 0; k < 2; ++k) \
        acc[ai][bj][m][n] = __builtin_amdgcn_mfma_f32_16x16x32_bf16(Bt[n][k], At[m][k], acc[ai][bj][m][n], 0, 0, 0); __builtin_amdgcn_s_setprio(0); } while (0)
#define PG8_WAIT_V(n) asm volatile("s_waitcnt vmcnt(" #n ")" ::: "memory")
#define PG8_WAIT_L(n) asm volatile("s_waitcnt lgkmcnt(" #n ")" ::: "memory")
#define PG8_BAR __builtin_amdgcn_s_barrier()
#define PG8_SCHED __builtin_amdgcn_sched_barrier(0)
    Unit cur, nxt; int ui = 0;
    if (!S.next(0, cur)) return;
    f32x4 acc[2][2][4][2];
#pragma unroll
    for (int a = 0; a < 2; ++a)
#pragma unroll
        for (int b = 0; b < 2; ++b)
#pragma unroll
            for (int m = 0; m < 4; ++m)
#pragma unroll
                for (int n = 0; n < 2; ++n) acc[a][b][m][n] = (f32x4){0.f, 0.f, 0.f, 0.f};
    bf16x8 At[4][2], B0[2][2], B1[2][2];
    const char* cA = (const char*)g.A + (size_t)cur.pm * tstep; const char* cB = (const char*)g.Bt + (size_t)cur.pn * tstep;
    S.a_ready(cur);
    if constexpr (SP2) {
        PG8_STAGE(PG8_SB(0, 0), cB, voffB); PG8_STAGE(PG8_SB(0, 1), cB + hstep, voffB); PG8_STAGE(PG8_SA(0, 0), cA, voffA); PG8_STAGE(PG8_SA(0, 1), cA + hstep, voffA);
        if (wr == 1) PG8_BAR;
        PG8_WAIT_V(2); PG8_BAR;
        PG8_STAGE(PG8_SB(1, 0), cB + kstep, voffB); PG8_STAGE(PG8_SA(1, 0), cA + kstep, voffA); PG8_STAGE(PG8_SB(1, 1), cB + hstep + kstep, voffB);
        PG8_WAIT_V(6); PG8_BAR;
    } else {
        PG8_STAGE(PG8_SB(0, 0), cB, voffB); PG8_STAGE(PG8_SA(0, 0), cA, voffA); PG8_STAGE(PG8_SB(0, 1), cB + hstep, voffB); PG8_STAGE(PG8_SA(0, 1), cA + hstep, voffA);
        if (wr == 1) PG8_BAR;
        PG8_WAIT_V(4); PG8_BAR;
        PG8_STAGE(PG8_SB(1, 0), cB + kstep, voffB); PG8_STAGE(PG8_SA(1, 0), cA + kstep, voffA); PG8_STAGE(PG8_SB(1, 1), cB + hstep + kstep, voffB);
        PG8_WAIT_V(6); PG8_BAR;
    }
    for (;;) {
        const bool has_next = S.next(ui + 1, nxt);
        const char* nA = has_next ? (const char*)g.A + (size_t)nxt.pm * tstep : cA; const char* nB = has_next ? (const char*)g.Bt + (size_t)nxt.pn * tstep : cB;
        for (int t = 0; t < nt; t += 2) {
            const bool last = (t == nt - 2);
            const char* a1 = cA + (size_t)(t + 1) * kstep;
            const char* a2 = last ? nA : cA + (size_t)(t + 2) * kstep; const char* b2 = last ? nB : cB + (size_t)(t + 2) * kstep;
            const char* a3 = a2 + kstep; const char* b3 = b2 + kstep;
            if (last && has_next) S.a_ready(nxt);
            if constexpr (SP2) {
            PG8_LDB(B0, 0, 0); PG8_LDB(B1, 0, 1); PG8_SCHED; PG8_LDA(At, 0, 0); PG8_STAGE(PG8_SA(1, 1), a1 + hstep, voffA);
            PG8_WAIT_V(8); PG8_WAIT_L(0); PG8_BAR; PG8_MMA(0, 0, At, B0); PG8_MMA(0, 1, At, B1); PG8_BAR; PG8_SCHED;
            PG8_LDA(At, 0, 1); PG8_STAGE(PG8_SB(0, 0), b2, voffB); PG8_STAGE(PG8_SB(0, 1), b2 + hstep, voffB); PG8_STAGE(PG8_SA(0, 0), a2, voffA);
            PG8_WAIT_V(8); PG8_WAIT_L(0); PG8_BAR; PG8_MMA(1, 0, At, B0); PG8_MMA(1, 1, At, B1); PG8_BAR; PG8_SCHED;
            PG8_LDB(B0, 1, 0); PG8_LDB(B1, 1, 1); PG8_SCHED; PG8_LDA(At, 1, 0); PG8_STAGE(PG8_SA(0, 1), a2 + hstep, voffA);
            PG8_WAIT_V(8); PG8_WAIT_L(0); PG8_BAR; PG8_MMA(0, 0, At, B0); PG8_MMA(0, 1, At, B1); PG8_BAR; PG8_SCHED;
            PG8_LDA(At, 1, 1); PG8_STAGE(PG8_SB(1, 0), b3, voffB); PG8_STAGE(PG8_SB(1, 1), b3 + hstep, voffB); PG8_STAGE(PG8_SA(1, 0), a3, voffA);
            PG8_WAIT_V(8); PG8_WAIT_L(0); PG8_BAR; PG8_MMA(1, 0, At, B0); PG8_MMA(1, 1, At, B1); PG8_BAR; PG8_SCHED;
            } else {
            PG8_LDB(B0, 0, 0); PG8_SCHED; PG8_LDA(At, 0, 0); PG8_STAGE(PG8_SA(1, 1), a1 + hstep, voffA);
            PG8_WAIT_L(8); PG8_BAR; PG8_WAIT_L(0); PG8_MMA(0, 0, At, B0); PG8_BAR; PG8_SCHED;
            PG8_LDB(B1, 0, 1); PG8_STAGE(PG8_SB(0, 0), b2, voffB);
            PG8_BAR; PG8_WAIT_L(0); PG8_MMA(0, 1, At, B1); PG8_BAR;
            PG8_LDA(At, 0, 1); PG8_STAGE(PG8_SA(0, 0), a2, voffA);
            PG8_BAR; PG8_WAIT_L(0); PG8_MMA(1, 0, At, B0); PG8_BAR; PG8_SCHED;
            PG8_STAGE(PG8_SB(0, 1), b2 + hstep, voffB);
            PG8_WAIT_V(6); PG8_BAR; PG8_MMA(1, 1, At, B1); PG8_BAR;
            PG8_LDB(B0, 1, 0); PG8_SCHED; PG8_LDA(At, 1, 0); PG8_STAGE(PG8_SA(0, 1), a2 + hstep, voffA);
            PG8_WAIT_L(8); PG8_BAR; PG8_WAIT_L(0); PG8_MMA(0, 0, At, B0); PG8_BAR; PG8_SCHED;
            PG8_LDB(B1, 1, 1); PG8_STAGE(PG8_SB(1, 0), b3, voffB);
            PG8_BAR; PG8_WAIT_L(0); PG8_MMA(0, 1, At, B1); PG8_BAR;
            PG8_LDA(At, 1, 1); PG8_STAGE(PG8_SA(1, 0), a3, voffA);
            PG8_BAR; PG8_WAIT_L(0); PG8_MMA(1, 0, At, B0); PG8_BAR; PG8_SCHED;
            PG8_STAGE(PG8_SB(1, 1), b3 + hstep, voffB);
            PG8_WAIT_V(6); PG8_BAR; PG8_MMA(1, 1, At, B1); PG8_BAR;
            }
        }
        if constexpr (ALIGN_EPI) { if (wr == 0) PG8_BAR; }
        if constexpr (!Epi::AFTER_DRAIN) { E(acc, cur, wr, wc, fr, fq); S.done(cur); }
        if (!has_next) break;
#pragma unroll
        for (int a = 0; a < 2; ++a)
#pragma unroll
            for (int b = 0; b < 2; ++b)
#pragma unroll
                for (int m = 0; m < 4; ++m)
#pragma unroll
                    for (int n = 0; n < 2; ++n) acc[a][b][m][n] = (f32x4){0.f, 0.f, 0.f, 0.f};
        cur = nxt; cA = nA; cB = nB; ++ui;
        if constexpr (ALIGN_EPI) { if (wr == 1) PG8_BAR; }
    }
    PG8_WAIT_V(0);
    if constexpr (!ALIGN_EPI) { if (wr == 0) PG8_BAR; }
    PG8_BAR;
    if constexpr (Epi::AFTER_DRAIN) { E.fused(acc, cur, wr, wc, fr, fq, lds, wid, lane); S.done(cur); }
#undef PG8_SA
#undef PG8_SB
#undef PG8_STAGE
#undef PG8_LDA
#undef PG8_LDB
#undef PG8_MMA
#undef PG8_WAIT_V
#undef PG8_WAIT_L
#undef PG8_BAR
#undef PG8_SCHED
}
}

#define GAS __attribute__((address_space(1)))
#define LAS __attribute__((address_space(3)))
typedef unsigned short bf16;
typedef unsigned u32x4 __attribute__((ext_vector_type(4)));
typedef unsigned u32x2 __attribute__((ext_vector_type(2)));
typedef float f32x4 __attribute__((ext_vector_type(4)));

constexpr int D = 2048, BATCH = 8, SEQ = 2048, M = BATCH * SEQ, DEPTH = 2, DFF = 5632;
constexpr int INW = 11312, ZP = 11520;
constexpr int C_HQ = 0, C_HF = 512, C_HI = 1024, C_HG = 1536, C_SU = 2048, C_NQ = 2560, C_KC = 3584, C_VC = 3840, C_KS = 4096, C_VS = 4352,
              C_KW = 4608, C_VW = 4864, C_ZA = 5120, C_ZB = 7168, C_ZC = 9216, C_NG = 11264;
constexpr int NG_SRC = 5120, NGW_ = 48;
constexpr int MODW = 9 * D;
constexpr float EPS = 1e-6f;
constexpr int NCMP = 127;
constexpr int NWAVES = 8;

constexpr size_t MiB = 1u << 20;
constexpr size_t WS_CTL = 0, CTL_ZERO_BYTES = 64 * 1024;
constexpr size_t WS_MOD = 1 * MiB;
constexpr size_t WS_SMALL = 3 * MiB;
constexpr size_t WS_KCH = 4 * MiB, WS_KCL = 4 * MiB + 512 * 1024, WS_VCT = 5 * MiB;
constexpr size_t WS_PHIT = 6 * MiB;
constexpr size_t WS_PEC = 7 * MiB;
constexpr size_t WS_W = 8 * MiB;
constexpr size_t W_WI1 = 0, SZ_WI = (size_t)2 * DFF * D * 2, SZ_WO = (size_t)D * DFF * 2;
constexpr size_t W_WO1 = W_WI1 + SZ_WI, W_WI2 = W_WO1 + SZ_WO, W_WO2 = W_WI2 + SZ_WI, W_WIN = W_WO2 + SZ_WO, SZ_WIN = (size_t)ZP * D * 2;
constexpr size_t W_HGP = W_WIN + SZ_WIN, W_GLU = W_HGP + (size_t)D * 512 * 2, W_NSP = W_GLU + (size_t)4096 * 512 * 2, W_WOUT = W_NSP + (size_t)D * 1024 * 2;
constexpr size_t LAYER_W = W_WOUT + (size_t)D * D * 2;
constexpr size_t WS_U = WS_W + 2 * LAYER_W;
constexpr size_t WS_ACT = WS_U + (size_t)M * D * 2;
constexpr size_t WS_Z = WS_ACT + (size_t)M * DFF * 2;
constexpr size_t WS_ORAW = WS_Z + (size_t)M * ZP * 2;
constexpr size_t WS_OA = WS_ACT + (size_t)M * D * 4;
constexpr size_t WS_YSG = WS_OA + (size_t)M * 512 * 2;
static_assert(WS_YSG + (size_t)M * 512 * 2 <= WS_ACT + (size_t)M * DFF * 2, "OA/YSG inside ACT");
constexpr size_t WS_HGDD = WS_YSG + (size_t)M * 512 * 2;
static_assert(WS_HGDD + (size_t)32 * 64 * 128 * 4 <= WS_ACT + (size_t)M * DFF * 2, "HGDD inside ACT");
constexpr size_t WS_OC = WS_ORAW + (size_t)M * 512 * 4;
constexpr size_t WS_VST = WS_OC + (size_t)M * 1024 * 2;
constexpr size_t WS_VWT = WS_VST + (size_t)8 * 4 * 64 * SEQ * 2;
constexpr size_t S5BT_L = (size_t)32 * 512 * 640 * 2, S5WT_L = (size_t)32 * 128 * 512 * 2, S5AL_L = 32 * 64 * 2 * 4;
constexpr size_t WS_S5BT = WS_VWT + (size_t)8 * 4 * 64 * SEQ * 2;
constexpr size_t WS_S5AE = WS_S5BT + 2 * S5BT_L;
constexpr size_t WS_S5WT = WS_S5AE + S5BT_L;
constexpr size_t WS_S5AL = WS_S5WT + 2 * S5WT_L;
constexpr size_t WS_END = WS_S5AL + 2 * S5AL_L;
static_assert(WS_END <= (size_t)1152 * MiB, "workspace map exceeds the guaranteed size");
static_assert((WS_U % 256) == 0 && (WS_ACT % 256) == 0 && (WS_Z % 256) == 0 && (WS_ORAW % 256) == 0, "alignment");

constexpr int CW_BAR = 1024;
constexpr int RING_BYTES = 131072, MISC_OFF = RING_BYTES + 320, LDS_BYTES = 147456;

__device__ __forceinline__ float bf2f(unsigned short b) { return __uint_as_float(((unsigned)b) << 16); }
__device__ __forceinline__ float bflo(unsigned w) { return __uint_as_float(w << 16); }
__device__ __forceinline__ float bfhi(unsigned w) { return __uint_as_float(w & 0xffff0000u); }
__device__ __forceinline__ unsigned f2bf(float f) { unsigned u = __float_as_uint(f); return (u + 0x7fffu + ((u >> 16) & 1u)) >> 16; }
__device__ __forceinline__ unsigned pk2(float lo, float hi) { return pg8::cvt_pk_bf16(lo, hi); }
__device__ __forceinline__ float sigm(float x) { return __builtin_amdgcn_rcpf(1.0f + __expf(-x)); }
__device__ __forceinline__ float siluf(float x) { return x * __builtin_amdgcn_rcpf(1.0f + __expf(-x)); }
__device__ __forceinline__ float gelu_tanh(float y) { const float a = 0.7978845608028654f * (y + 0.044715f * y * y * y); const float e = __expf(2.0f * a); const float th = 1.0f - 2.0f * __builtin_amdgcn_rcpf(e + 1.0f); return 0.5f * y * (1.0f + th); }
__device__ __forceinline__ float wave_sum(float v) {
#pragma unroll
    for (int o = 1; o < 64; o <<= 1) v += __shfl_xor(v, o);
    return v;
}
#define LDS_WAIT() asm volatile("s_waitcnt lgkmcnt(0)" ::: "memory")

#define XB_TMO      128
#define XB_XCNT(j)  (256  + 64 * (j))
#define XB_XSUB(j)  (1280 + 64 * (j))
#define XB_XGEN(j)  (2304 + 64 * (j))
#define XB_TOP      3328
#define XB_TOPGEN   3392
#define XCD_BAR_WORDS 3456
#define XB_SPIN_CAP (1u << 22)
__device__ __forceinline__ unsigned xb_ld(unsigned* p)              { return __hip_atomic_load(p, __ATOMIC_RELAXED, __HIP_MEMORY_SCOPE_AGENT); }
__device__ __forceinline__ unsigned xb_add(unsigned* p, unsigned v) { return __hip_atomic_fetch_add(p, v, __ATOMIC_RELAXED, __HIP_MEMORY_SCOPE_AGENT); }
__device__ __forceinline__ unsigned xb_xcc_id() { return (unsigned)__builtin_amdgcn_s_getreg((3 << 11) | 20) & 0xFu; }
#define XB_SPIN(cond, bar) do { unsigned _sp = 0; while (cond) { __builtin_amdgcn_s_sleep(1); \
    if ((++_sp & 255u) == 0u) { if (xb_ld(&(bar)[XB_TMO])) break; if (_sp > XB_SPIN_CAP) { atomicAdd(&(bar)[XB_TMO], 1u); break; } } } } while (0)
struct XcdBarrier { unsigned* bar; unsigned x; volatile LAS unsigned* st; };
__device__ __forceinline__ XcdBarrier xcd_barrier_post(unsigned* bar, volatile LAS unsigned* st) {
    XcdBarrier b; b.bar = bar; b.x = xb_xcc_id(); b.st = st;
    if (threadIdx.x == 0) (void)xb_add(&bar[XB_XCNT(b.x)], 1u);
    return b;
}
__device__ __forceinline__ void xcd_barrier_complete(unsigned* bar, unsigned x, unsigned& nloc, unsigned& nx) {
    const unsigned G = gridDim.x * gridDim.y * gridDim.z;
    unsigned sum, cnt, mine, sp = 0u;
    for (;;) {
        sum = 0u; cnt = 0u; mine = 0u;
#pragma unroll
        for (unsigned j = 0; j < 16; ++j) { const unsigned c = xb_ld(&bar[XB_XCNT(j)]); sum += c; cnt += (c > 0u) ? 1u : 0u; mine = (j == x) ? c : mine; }
        if (sum == G) break;
        __builtin_amdgcn_s_sleep(1);
        if ((++sp & 255u) == 0u) { if (xb_ld(&bar[XB_TMO])) break; if (sp > XB_SPIN_CAP) { atomicAdd(&bar[XB_TMO], 1u); break; } }
    }
    nloc = mine > 0u ? mine : 1u; nx = cnt > 0u ? cnt : 1u;
}
__device__ __forceinline__ void xcd_barrier(const XcdBarrier& b) {
    asm volatile("s_waitcnt vmcnt(0)" ::: "memory");
    __syncthreads();
    if (threadIdx.x == 0) {
        unsigned* bar = b.bar;
        __builtin_amdgcn_s_waitcnt(0);
        unsigned nloc = b.st[0], nx = b.st[1];
        if (nloc == 0u) { xcd_barrier_complete(bar, b.x, nloc, nx); b.st[0] = nloc; b.st[1] = nx; }
        const unsigned old = xb_add(&bar[XB_XSUB(b.x)], 1u);
        const unsigned gen = old / nloc;
        if (old + 1u == (gen + 1u) * nloc) {
            __builtin_amdgcn_fence(__ATOMIC_RELEASE, "agent");
            asm volatile("s_waitcnt vmcnt(0)" ::: "memory");
            const unsigned og = xb_add(&bar[XB_TOP], 1u);
            const unsigned tg = og / nx;
            if (og + 1u == (tg + 1u) * nx) xb_add(&bar[XB_TOPGEN], 1u);
            else XB_SPIN(xb_ld(&bar[XB_TOPGEN]) == tg, bar);
            __builtin_amdgcn_fence(__ATOMIC_ACQUIRE, "agent");
            xb_add(&bar[XB_XGEN(b.x)], 1u);
            asm volatile("s_waitcnt vmcnt(0)" ::: "memory");
        } else {
            XB_SPIN(xb_ld(&bar[XB_XGEN(b.x)]) == gen, bar);
            __builtin_amdgcn_fence(__ATOMIC_ACQUIRE, "agent");
            asm volatile("s_waitcnt vmcnt(0)" ::: "memory");
        }
    }
    __syncthreads();
}

using pg8::Unit; using pg8::cvt_pk_bf16;
struct EpiStoreBf16 {
    static constexpr bool PERM = true, AFTER_DRAIN = false;
    bf16* O; int ldc;
    __device__ __forceinline__ void operator()(const f32x4 (&acc)[2][2][4][2], const Unit& u, int wr, int wc, int fr, int fq) const {
        const int row0 = u.pm * 256 + wr * 64 + fr, col0 = u.pn * 256 + wc * 32 + 8 * fq;
#pragma unroll
        for (int ai = 0; ai < 2; ++ai)
#pragma unroll
            for (int m = 0; m < 4; ++m) { bf16* rowp = O + (size_t)(row0 + ai * 128 + m * 16) * ldc + col0;
#pragma unroll
                for (int bj = 0; bj < 2; ++bj) { const f32x4 v0 = acc[ai][bj][m][0], v1 = acc[ai][bj][m][1];
                    u32x4 w; w.x = cvt_pk_bf16(v0[0], v0[1]); w.y = cvt_pk_bf16(v0[2], v0[3]); w.z = cvt_pk_bf16(v1[0], v1[1]); w.w = cvt_pk_bf16(v1[2], v1[3]);
                    *(u32x4*)(rowp + bj * 128) = w; } }
    }
};
struct EpiSwiGLU {
    static constexpr bool PERM = true, AFTER_DRAIN = false;
    bf16* O; int ldc;
    __device__ __forceinline__ void operator()(const f32x4 (&acc)[2][2][4][2], const Unit& u, int wr, int wc, int fr, int fq) const {
        const int row0 = u.pm * 256 + wr * 64 + fr, col0 = u.pn * 128 + wc * 32 + 8 * fq;
#pragma unroll
        for (int ai = 0; ai < 2; ++ai)
#pragma unroll
            for (int m = 0; m < 4; ++m) { bf16* rowp = O + (size_t)(row0 + ai * 128 + m * 16) * ldc + col0;
                float r[8];
#pragma unroll
                for (int n = 0; n < 2; ++n)
#pragma unroll
                    for (int j = 0; j < 4; ++j) { const float g = acc[ai][0][m][n][j], up = acc[ai][1][m][n][j]; r[n * 4 + j] = siluf(g) * up; }
                u32x4 w; w.x = cvt_pk_bf16(r[0], r[1]); w.y = cvt_pk_bf16(r[2], r[3]); w.z = cvt_pk_bf16(r[4], r[5]); w.w = cvt_pk_bf16(r[6], r[7]);
                *(u32x4*)rowp = w; }
    }
};
struct EpiResid {
    static constexpr bool PERM = false, AFTER_DRAIN = false;
    const float* hin; float* hout; const float* gate; float scale;
    __device__ __forceinline__ void operator()(const f32x4 (&acc)[2][2][4][2], const Unit& u, int wr, int wc, int fr, int fq) const {
        const int row0 = u.pm * 256 + wr * 64 + fr, col0 = u.pn * 256 + wc * 32 + 4 * fq, b = u.pm >> 3;
        f32x4 gv[2][2];
#pragma unroll
        for (int bj = 0; bj < 2; ++bj)
#pragma unroll
            for (int n = 0; n < 2; ++n) gv[bj][n] = *(const f32x4*)(gate + (size_t)b * MODW + col0 + bj * 128 + n * 16) * scale;
#pragma unroll
        for (int ai = 0; ai < 2; ++ai)
#pragma unroll
            for (int m = 0; m < 4; ++m) { const size_t off = (size_t)(row0 + ai * 128 + m * 16) * D + col0;
#pragma unroll
                for (int bj = 0; bj < 2; ++bj)
#pragma unroll
                    for (int n = 0; n < 2; ++n) { const f32x4 hv = *(const f32x4*)(hin + off + bj * 128 + n * 16);
                        *(f32x4*)(hout + off + bj * 128 + n * 16) = hv + gv[bj][n] * acc[ai][bj][m][n]; } }
    }
};
__device__ __forceinline__ void sig8(const u32x4 w, float (&s)[8]) {
    s[0] = sigm(bflo(w.x)); s[1] = sigm(bfhi(w.x)); s[2] = sigm(bflo(w.y)); s[3] = sigm(bfhi(w.y));
    s[4] = sigm(bflo(w.z)); s[5] = sigm(bfhi(w.z)); s[6] = sigm(bflo(w.w)); s[7] = sigm(bfhi(w.w));
}
struct EpiMergeB {
    static constexpr bool PERM = true, AFTER_DRAIN = false;
    const bf16* zg; bf16* O;
    __device__ __forceinline__ void operator()(const f32x4 (&acc)[2][2][4][2], const Unit& u, int wr, int wc, int fr, int fq) const {
        const int row0 = u.pm * 256 + wr * 64 + fr, col0 = u.pn * 128 + wc * 32 + 8 * fq;
#pragma unroll
        for (int ai = 0; ai < 2; ++ai)
#pragma unroll
            for (int m = 0; m < 4; ++m) { const int row = row0 + ai * 128 + m * 16;
                const u32x4 w = *(const u32x4*)(zg + (size_t)row * ZP + col0); float s[8]; sig8(w, s);
                float v[8];
#pragma unroll
                for (int j = 0; j < 4; ++j) { v[j] = s[j] * acc[ai][0][m][0][j] * sigm(acc[ai][1][m][0][j]); v[4 + j] = s[4 + j] * acc[ai][0][m][1][j] * sigm(acc[ai][1][m][1][j]); }
                u32x4 o; o.x = cvt_pk_bf16(v[0], v[1]); o.y = cvt_pk_bf16(v[2], v[3]); o.z = cvt_pk_bf16(v[4], v[5]); o.w = cvt_pk_bf16(v[6], v[7]);
                *(u32x4*)(O + (size_t)row * D + col0) = o; }
    }
};
struct EpiMergeAcc {
    static constexpr bool PERM = true, AFTER_DRAIN = false;
    const bf16* zg; bf16* O;
    __device__ __forceinline__ void operator()(const f32x4 (&acc)[2][2][4][2], const Unit& u, int wr, int wc, int fr, int fq) const {
        const int row0 = u.pm * 256 + wr * 64 + fr, col0 = u.pn * 256 + wc * 32 + 8 * fq;
#pragma unroll
        for (int ai = 0; ai < 2; ++ai)
#pragma unroll
            for (int m = 0; m < 4; ++m) { const int row = row0 + ai * 128 + m * 16;
#pragma unroll
                for (int bj = 0; bj < 2; ++bj) { const u32x4 w = *(const u32x4*)(zg + (size_t)row * ZP + col0 + bj * 128); float s[8]; sig8(w, s);
                    bf16* op = O + (size_t)row * D + col0 + bj * 128;
                    const u32x4 p = *(const u32x4*)op;
                    const f32x4 a = acc[ai][bj][m][0], c = acc[ai][bj][m][1];
                    u32x4 o; o.x = cvt_pk_bf16(bflo(p.x) + s[0] * a[0], bfhi(p.x) + s[1] * a[1]); o.y = cvt_pk_bf16(bflo(p.y) + s[2] * a[2], bfhi(p.y) + s[3] * a[3]);
                    o.z = cvt_pk_bf16(bflo(p.z) + s[4] * c[0], bfhi(p.z) + s[5] * c[1]); o.w = cvt_pk_bf16(bflo(p.w) + s[6] * c[2], bfhi(p.w) + s[7] * c[3]);
                    *(u32x4*)op = o; } }
    }
};

__device__ __forceinline__ void transpose_item(const float* W, int K, int N, int Npad, bf16* WT, int maptype, int H, int item, int lane) {
    const int nblk = Npad / 64, kb = item / nblk, nb = item - kb * nblk, k0 = 64 * kb, n0 = 64 * nb;
    const int nn = n0 + lane; const bool ok = nn < N;
    const float* src = W + (size_t)k0 * N + (ok ? nn : 0);
    float v[64];
#pragma unroll
    for (int i = 0; i < 64; ++i) v[i] = __builtin_nontemporal_load(src + (size_t)i * N);
    int d0 = n0;
    if (maptype == 1) { const int hb = n0 / H, rem = n0 - hb * H; d0 = (rem >> 7) * 256 + hb * 128 + (rem & 127); }
    int drow = d0 + lane;
    if (maptype == 2) drow = (nn >= N || nn < NG_SRC) ? nn : (nn < NG_SRC + NGW_ ? C_NG + (nn - NG_SRC) : nn - NGW_);
    u32x4* dst = (u32x4*)(WT + (size_t)drow * K + k0);
#pragma unroll
    for (int j = 0; j < 8; ++j) { u32x4 o;
        o.x = ok ? pk2(v[8 * j + 0], v[8 * j + 1]) : 0u; o.y = ok ? pk2(v[8 * j + 2], v[8 * j + 3]) : 0u; o.z = ok ? pk2(v[8 * j + 4], v[8 * j + 5]) : 0u; o.w = ok ? pk2(v[8 * j + 6], v[8 * j + 7]) : 0u;
        dst[j] = o; }
}

struct Args { const float* in[31]; float* out; unsigned char* ws; };
#define KIN(i) (((const float* const*)__builtin_amdgcn_kernarg_segment_ptr())[(i)])
#define KOUT() (((float* const*)__builtin_amdgcn_kernarg_segment_ptr())[31])
#define KWS() (((unsigned char* const*)__builtin_amdgcn_kernarg_segment_ptr())[32])

__device__ __forceinline__ void prologue_transposes(int l, LAS unsigned char* lds, int gw, int NGW, int wave, int lane) {
    constexpr int I_WI = (D / 64) * (2 * DFF / 64), I_WO = (DFF / 64) * (D / 64), I_WIN = (D / 64) * (ZP / 64), I_HGP = (512 / 64) * (D / 64),
                  I_GLU = (512 / 64) * (4096 / 64), I_NSP = (1024 / 64) * (D / 64), I_WOUT = (D / 64) * (D / 64);
    constexpr int I_LAYER = 2 * (I_WI + I_WO) + I_WIN + I_HGP + I_GLU + I_NSP + I_WOUT;
    for (int it = gw; it < I_LAYER; it += NGW) {
        int r = it;
        const float* src; size_t woff; int K, N, Npad, mt = 0, H = 1;
        if (r < I_WI) { src = KIN(5) + (size_t)l * D * 2 * DFF; K = D; N = 2 * DFF; Npad = N; woff = W_WI1; mt = 1; H = DFF; }
        else if ((r -= I_WI) < I_WO) { src = KIN(6) + (size_t)l * DFF * D; K = DFF; N = D; Npad = N; woff = W_WO1; }
        else if ((r -= I_WO) < I_WI) { src = KIN(7) + (size_t)l * D * 2 * DFF; K = D; N = 2 * DFF; Npad = N; woff = W_WI2; mt = 1; H = DFF; }
        else if ((r -= I_WI) < I_WO) { src = KIN(8) + (size_t)l * DFF * D; K = DFF; N = D; Npad = N; woff = W_WO2; }
        else if ((r -= I_WO) < I_WIN) { src = KIN(9) + (size_t)l * D * INW; K = D; N = INW; Npad = ZP; woff = W_WIN; mt = 2; }
        else if ((r -= I_WIN) < I_HGP) { src = KIN(12) + (size_t)l * 512 * D; K = 512; N = D; Npad = N; woff = W_HGP; }
        else if ((r -= I_HGP) < I_GLU) { src = KIN(21) + (size_t)l * 512 * 4096; K = 512; N = 4096; Npad = N; woff = W_GLU; mt = 1; H = 2048; }
        else if ((r -= I_GLU) < I_NSP) { src = KIN(28) + (size_t)l * 1024 * D; K = 1024; N = D; Npad = N; woff = W_NSP; }
        else { r -= I_NSP; src = KIN(30) + (size_t)l * D * D; K = D; N = D; Npad = N; woff = W_WOUT; }
        transpose_item(src, K, N, Npad, (bf16*)(KWS() + WS_W + (size_t)l * LAYER_W + woff), mt, H, r, lane);
    }
}

__device__ __forceinline__ void prologue_mod(const Args& a, LAS unsigned char* lds, int tid, int G) {
    LAS float* cact = (LAS float*)lds;
    LAS float* red = (LAS float*)(lds + 65536);
    const float* c = KIN(1); const float* ada_w = KIN(2); const float* ada_b = KIN(3);
    float* mod = (float*)(KWS() + WS_MOD);
    for (int i = tid; i < BATCH * D; i += 512) { const int b = i / D, k = i - b * D; cact[k * 8 + b] = siluf(c[i]); }
    __syncthreads();
    for (int unit = blockIdx.x; unit < 256; unit += G) {
        const int l = unit >> 7, colbase = (unit & 127) * 144;
        const float* W = ada_w + (size_t)l * D * MODW + colbase;
        if (tid < 504) {
            const int c4 = tid % 36, kg = tid / 36;
            f32x4 acc[8];
#pragma unroll
            for (int b = 0; b < 8; ++b) acc[b] = (f32x4){0.f, 0.f, 0.f, 0.f};
#pragma unroll 4
            for (int k = kg; k < D; k += 14) {
                const f32x4 w = __builtin_nontemporal_load((const f32x4*)(W + (size_t)k * MODW + c4 * 4));
                const f32x4 ca0 = *(const LAS f32x4*)(cact + k * 8), ca1 = *(const LAS f32x4*)(cact + k * 8 + 4);
                acc[0] += w * ca0[0]; acc[1] += w * ca0[1]; acc[2] += w * ca0[2]; acc[3] += w * ca0[3];
                acc[4] += w * ca1[0]; acc[5] += w * ca1[1]; acc[6] += w * ca1[2]; acc[7] += w * ca1[3];
            }
#pragma unroll
            for (int b = 0; b < 8; ++b) *(LAS f32x4*)(red + (kg * 36 + c4) * 32 + b * 4) = acc[b];
        }
        __syncthreads();
        for (int o = tid; o < 36 * 32; o += 512) {
            const int c4 = o >> 5, r = o & 31; float s = 0.f;
#pragma unroll
            for (int kg = 0; kg < 14; ++kg) s += red[(kg * 36 + c4) * 32 + r];
            const int b = r >> 2, j = r & 3, col = colbase + c4 * 4 + j;
            mod[((size_t)l * 8 + b) * MODW + col] = s + ada_b[(size_t)l * MODW + col];
        }
        __syncthreads();
    }
}

__device__ __forceinline__ void prologue_small(const Args& a, int tid) {
    float* biasTab = (float*)(KWS() + WS_SMALL); float* lbv = biasTab + 128 * 16;
    const float* rel = KIN(29); const float* lbl = KIN(10);
    if (blockIdx.x == 0) {
        for (int i = tid; i < 128 * 16; i += 512) { const int d = i >> 4, hd = i & 15; int bk = d;
            if (d >= 16) { bk = 16 + (int)(logf((float)d / 16.0f) / logf(8.0f) * 16.0f); bk = bk < 31 ? bk : 31; }
            biasTab[i] = rel[bk * 16 + hd]; }
    }
    if (blockIdx.x == 1 % gridDim.x) {
        for (int i = tid; i < 512; i += 512) { const float a0 = lbl[i], a1 = lbl[512 + i], mx = fmaxf(a0, a1); const float e0 = expf(a0 - mx), e1 = expf(a1 - mx), s = e0 + e1;
            const float p0 = e0 / s, p1 = e1 / s; const float c0 = p0, c1 = p0 + p1; lbv[i] = c0 - c0; lbv[512 + i] = c1 - c0; }
    }
}

__device__ __forceinline__ void norm_phase(const float* h, const float* gain, const float* shift, const float* scale, bf16* U, int gw, int NGW, int lane) {
    for (int m0 = gw * 8; m0 < M; m0 += NGW * 8) {
        const int b = m0 / SEQ;
        f32x4 gg[8], sh[8];
#pragma unroll
        for (int j = 0; j < 8; ++j) { const int col = (lane + 64 * j) * 4;
            const f32x4 g = *(const f32x4*)(gain + col), sc = *(const f32x4*)(scale + (size_t)b * MODW + col); sh[j] = *(const f32x4*)(shift + (size_t)b * MODW + col);
#pragma unroll
            for (int e = 0; e < 4; ++e) gg[j][e] = g[e] * (1.0f + sc[e]); }
#pragma unroll 2
        for (int r = 0; r < 8; ++r) { const int m = m0 + r;
            const f32x4* xr = (const f32x4*)(h + (size_t)m * D) + lane;
            f32x4 v[8]; float ss = 0.f;
#pragma unroll
            for (int j = 0; j < 8; ++j) { v[j] = xr[64 * j]; ss += (v[j][0] * v[j][0] + v[j][1] * v[j][1]) + (v[j][2] * v[j][2] + v[j][3] * v[j][3]); }
            const float rstd = rsqrtf(wave_sum(ss) * (1.0f / D) + EPS);
            u32x2* o = (u32x2*)(U + (size_t)m * D) + lane;
#pragma unroll
            for (int j = 0; j < 8; ++j) { f32x4 y;
#pragma unroll
                for (int e = 0; e < 4; ++e) y[e] = (v[j][e] * rstd) * gg[j][e] + sh[j][e];
                u32x2 w; w.x = pk2(y[0], y[1]); w.y = pk2(y[2], y[3]); o[64 * j] = w; }
        }
    }
}

__device__ __forceinline__ void hgrn_phase(const bf16* z, const float* lbv, float* oraw, LAS unsigned char* lds, int tid, int G) {
    LAS float* red = (LAS float*)lds;
    LAS float* pb = (LAS float*)(lds + 34816);
    const int kq = tid >> 4, v = tid & 15, ptok = tid >> 5, pk = (tid & 31) * 4;
    __syncthreads();
    for (int unit = blockIdx.x; unit < 256; unit += G) {
        const int b = unit >> 5, h = (unit >> 3) & 3, vs = unit & 7;
        float lbp[4], omlp[4], s[4];
#pragma unroll
        for (int j = 0; j < 4; ++j) { lbp[j] = lbv[h * 128 + pk + j]; omlp[j] = 1.0f - lbp[j]; s[j] = 0.f; }
        const bf16* zq = z + ((size_t)b * SEQ + ptok) * ZP + C_HQ + h * 128 + pk;
        const bf16* zf = z + ((size_t)b * SEQ + ptok) * ZP + C_HF + h * 128 + pk;
        const bf16* zi = z + (size_t)(b * SEQ) * ZP + C_HI + h * 128 + vs * 16 + v;
#define HG_PREP(c_, buf_) do { const size_t o_ = (size_t)(c_) * 16 * ZP; const u32x2 q2 = *(const u32x2*)(zq + o_), f2 = *(const u32x2*)(zf + o_); \
            const float qv_[4] = {bflo(q2.x), bfhi(q2.x), bflo(q2.y), bfhi(q2.y)}, fv_[4] = {bflo(f2.x), bfhi(f2.x), bflo(f2.y), bfhi(f2.y)}; f32x4 F_, K_, Q_; \
            _Pragma("unroll") for (int j = 0; j < 4; ++j) { const float x_ = fminf(fmaxf(fv_[j], -30.f), 30.f); const float e_ = __expf(-x_), r_ = __builtin_amdgcn_rcpf(1.0f + e_); \
                F_[j] = lbp[j] + omlp[j] * r_; K_[j] = omlp[j] * (e_ * r_); Q_[j] = siluf(qv_[j]); } \
            LAS float* d_ = pb + (buf_) * 6144 + ptok * 128 + pk; *(LAS f32x4*)d_ = F_; *(LAS f32x4*)(d_ + 2048) = K_; *(LAS f32x4*)(d_ + 4096) = Q_; } while (0)
        HG_PREP(0, 0);
        unsigned short ri[16];
#pragma unroll
        for (int tt = 0; tt < 16; ++tt) ri[tt] = zi[(size_t)tt * ZP];
        __syncthreads();
        for (int c = 0; c < SEQ / 16; ++c) {
            const int cn = (c + 1 < SEQ / 16) ? c + 1 : c;
            if (c + 1 < SEQ / 16) HG_PREP(c + 1, (c + 1) & 1);
            const LAS float* tb_ = pb + (c & 1) * 6144 + kq * 4;
#pragma unroll
            for (int tt = 0; tt < 16; ++tt) {
                const f32x4 F = *(const LAS f32x4*)(tb_ + tt * 128), K = *(const LAS f32x4*)(tb_ + 2048 + tt * 128), Q = *(const LAS f32x4*)(tb_ + 4096 + tt * 128);
                const float iv = bf2f(ri[tt]); ri[tt] = zi[(size_t)(cn * 16 + tt) * ZP];
                float part = 0.f;
#pragma unroll
                for (int j = 0; j < 4; ++j) { s[j] = F[j] * s[j] + K[j] * iv; part += Q[j] * s[j]; }
                red[tt * 528 + kq * 16 + v] = part;
            }
            __syncthreads();
            if (tid < 256) { const int tt = tid >> 4, vv = tid & 15; float sum = 0.f;
#pragma unroll
                for (int k2 = 0; k2 < 32; ++k2) sum += red[tt * 528 + k2 * 16 + vv];
                oraw[(size_t)(b * SEQ + c * 16 + tt) * 512 + h * 128 + vs * 16 + vv] = sum; }
            __syncthreads();
        }
#undef HG_PREP
    }
}
__device__ __forceinline__ void hgrn_post_phase(const float* oraw, const bf16* z, const float* onorm, bf16* oa, int gw, int NGW, int lane) {
    const float g0 = onorm[2 * lane], g1 = onorm[2 * lane + 1];
    for (int it = gw; it < M * 4; it += NGW) {
        const int row = it >> 2, h = it & 3;
        const float2 o = *(const float2*)(oraw + (size_t)row * 512 + h * 128 + 2 * lane);
        const float r = rsqrtf(wave_sum(o.x * o.x + o.y * o.y) * (1.0f / 128.0f) + EPS);
        const unsigned gw2 = *(const unsigned*)(z + (size_t)row * ZP + C_HG + h * 128 + 2 * lane);
        *(unsigned*)(oa + (size_t)row * 512 + h * 128 + 2 * lane) = pk2(o.x * r * g0 * siluf(bflo(gw2)), o.y * r * g1 * siluf(bfhi(gw2)));
    }
}

__device__ __forceinline__ void s5_phase(const bf16* z, const Args& a, int l, bf16* ysg, int wave, int lane, int G) {
    if (wave != 0) return;
    const float* a_re = KIN(13) + l * 32 * 64; const float* a_im = KIN(14) + l * 32 * 64; const float* log_dt = KIN(15) + l * 32;
    const float* b_re = KIN(16) + l * 32 * 64 * 16; const float* b_im = KIN(17) + l * 32 * 64 * 16;
    const float* c_re = KIN(18) + l * 32 * 16 * 64; const float* c_im = KIN(19) + l * 32 * 16 * 64; const float* dsk = KIN(20) + l * 512;
    for (int unit = blockIdx.x; unit < 256; unit += G) {
        const int b = unit >> 5, g = unit & 31, n = lane;
        const float are = fminf(a_re[g * 64 + n], -1e-4f), aim = a_im[g * 64 + n], dt = expf(log_dt[g]);
        const float mag = expf(dt * are), abre = mag * cosf(dt * aim), abim = mag * sinf(dt * aim);
        const float den = are * are + aim * aim, nr = abre - 1.0f;
        const float zre = (nr * are + abim * aim) / den, zim = (abim * are - nr * aim) / den;
        float bbr[16], bbi[16], cr[16], ci[16], dl[16];
#pragma unroll
        for (int p = 0; p < 16; ++p) { const float br = b_re[(g * 64 + n) * 16 + p], bi = b_im[(g * 64 + n) * 16 + p];
            bbr[p] = zre * br - zim * bi; bbi[p] = zre * bi + zim * br; cr[p] = c_re[(g * 16 + p) * 64 + n]; ci[p] = c_im[(g * 16 + p) * 64 + n];
            dl[p] = (lane == 0) ? dsk[g * 16 + p] : 0.f; }
        float xr = 0.f, xi = 0.f;
        const bf16* zu = z + (size_t)(b * SEQ) * ZP + C_SU + g * 16;
        for (int t0 = 0; t0 < SEQ; t0 += 8) {
            u32x4 raw[8][2];
#pragma unroll
            for (int i = 0; i < 8; ++i) { raw[i][0] = *(const u32x4*)(zu + (size_t)(t0 + i) * ZP); raw[i][1] = *(const u32x4*)(zu + (size_t)(t0 + i) * ZP + 8); }
#pragma unroll
            for (int i = 0; i < 8; ++i) {
                float u[16];
#pragma unroll
                for (int hh = 0; hh < 2; ++hh) { u[hh * 8 + 0] = bflo(raw[i][hh].x); u[hh * 8 + 1] = bfhi(raw[i][hh].x); u[hh * 8 + 2] = bflo(raw[i][hh].y); u[hh * 8 + 3] = bfhi(raw[i][hh].y);
                    u[hh * 8 + 4] = bflo(raw[i][hh].z); u[hh * 8 + 5] = bfhi(raw[i][hh].z); u[hh * 8 + 6] = bflo(raw[i][hh].w); u[hh * 8 + 7] = bfhi(raw[i][hh].w); }
                float bur = 0.f, bui = 0.f;
#pragma unroll
                for (int p = 0; p < 16; ++p) { bur += bbr[p] * u[p]; bui += bbi[p] * u[p]; }
                const float nxr = abre * xr - abim * xi + bur, nxi = abre * xi + abim * xr + bui; xr = nxr; xi = nxi;
                float vals[16];
#pragma unroll
                for (int p = 0; p < 16; ++p) vals[p] = xr * cr[p] - xi * ci[p] + dl[p] * u[p];
#pragma unroll
                for (int i2 = 0; i2 < 8; ++i2) { const bool bt = (lane & 32) != 0; const float keep = bt ? vals[8 + i2] : vals[i2], send = bt ? vals[i2] : vals[8 + i2]; vals[i2] = keep + __shfl_xor(send, 32); }
#pragma unroll
                for (int i2 = 0; i2 < 4; ++i2) { const bool bt = (lane & 16) != 0; const float keep = bt ? vals[4 + i2] : vals[i2], send = bt ? vals[i2] : vals[4 + i2]; vals[i2] = keep + __shfl_xor(send, 16); }
#pragma unroll
                for (int i2 = 0; i2 < 2; ++i2) { const bool bt = (lane & 8) != 0; const float keep = bt ? vals[2 + i2] : vals[i2], send = bt ? vals[i2] : vals[2 + i2]; vals[i2] = keep + __shfl_xor(send, 8); }
                { const bool bt = (lane & 4) != 0; const float keep = bt ? vals[1] : vals[0], send = bt ? vals[0] : vals[1]; vals[0] = keep + __shfl_xor(send, 4); }
                float y = vals[0]; y += __shfl_xor(y, 2); y += __shfl_xor(y, 1);
                if ((lane & 3) == 0) ysg[(size_t)(b * SEQ + t0 + i) * 512 + g * 16 + (lane >> 2)] = (bf16)f2bf(gelu_tanh(y));
            }
        }
    }
}

__device__ __forceinline__ void s5_phase_nostore(const bf16* z, const Args& a, int l, bf16* ysg, int wave, int lane, int G) {
    if (wave != 0) return;
    const float* a_re = KIN(13) + l * 32 * 64; const float* a_im = KIN(14) + l * 32 * 64; const float* log_dt = KIN(15) + l * 32;
    const float* b_re = KIN(16) + l * 32 * 64 * 16; const float* b_im = KIN(17) + l * 32 * 64 * 16;
    const float* c_re = KIN(18) + l * 32 * 16 * 64; const float* c_im = KIN(19) + l * 32 * 16 * 64; const float* dsk = KIN(20) + l * 512;
    for (int unit = blockIdx.x; unit < 256; unit += G) {
        const int b = unit >> 5, g = unit & 31, n = lane;
        const float are = fminf(a_re[g * 64 + n], -1e-4f), aim = a_im[g * 64 + n], dt = expf(log_dt[g]);
        const float mag = expf(dt * are), abre = mag * cosf(dt * aim), abim = mag * sinf(dt * aim);
        const float den = are * are + aim * aim, nr = abre - 1.0f;
        const float zre = (nr * are + abim * aim) / den, zim = (abim * are - nr * aim) / den;
        float bbr[16], bbi[16], cr[16], ci[16], dl[16];
#pragma unroll
        for (int p = 0; p < 16; ++p) { const float br = b_re[(g * 64 + n) * 16 + p], bi = b_im[(g * 64 + n) * 16 + p];
            bbr[p] = zre * br - zim * bi; bbi[p] = zre * bi + zim * br; cr[p] = c_re[(g * 16 + p) * 64 + n]; ci[p] = c_im[(g * 16 + p) * 64 + n];
            dl[p] = (lane == 0) ? dsk[g * 16 + p] : 0.f; }
        float xr = 0.f, xi = 0.f;
        const bf16* zu = z + (size_t)(b * SEQ) * ZP + C_SU + g * 16;
        for (int t0 = 0; t0 < 8 * (int)(bbr[0] + bbi[3] + cr[5] + ci[7] + dl[2] == 123456.7f); t0 += 8) {
            u32x4 raw[8][2];
#pragma unroll
            for (int i = 0; i < 8; ++i) { raw[i][0] = *(const u32x4*)(zu + (size_t)(t0 + i) * ZP); raw[i][1] = *(const u32x4*)(zu + (size_t)(t0 + i) * ZP + 8); }
#pragma unroll
            for (int i = 0; i < 8; ++i) {
                float u[16];
#pragma unroll
                for (int hh = 0; hh < 2; ++hh) { u[hh * 8 + 0] = bflo(raw[i][hh].x); u[hh * 8 + 1] = bfhi(raw[i][hh].x); u[hh * 8 + 2] = bflo(raw[i][hh].y); u[hh * 8 + 3] = bfhi(raw[i][hh].y);
                    u[hh * 8 + 4] = bflo(raw[i][hh].z); u[hh * 8 + 5] = bfhi(raw[i][hh].z); u[hh * 8 + 6] = bflo(raw[i][hh].w); u[hh * 8 + 7] = bfhi(raw[i][hh].w); }
                float bur = 0.f, bui = 0.f;
#pragma unroll
                for (int p = 0; p < 16; ++p) { bur += bbr[p] * u[p]; bui += bbi[p] * u[p]; }
                const float nxr = abre * xr - abim * xi + bur, nxi = abre * xi + abim * xr + bui; xr = nxr; xi = nxi;
                float vals[16];
#pragma unroll
                for (int p = 0; p < 16; ++p) vals[p] = xr * cr[p] - xi * ci[p] + dl[p] * u[p];
#pragma unroll
                for (int i2 = 0; i2 < 8; ++i2) { const bool bt = (lane & 32) != 0; const float keep = bt ? vals[8 + i2] : vals[i2], send = bt ? vals[i2] : vals[8 + i2]; vals[i2] = keep + __shfl_xor(send, 32); }
#pragma unroll
                for (int i2 = 0; i2 < 4; ++i2) { const bool bt = (lane & 16) != 0; const float keep = bt ? vals[4 + i2] : vals[i2], send = bt ? vals[i2] : vals[4 + i2]; vals[i2] = keep + __shfl_xor(send, 16); }
#pragma unroll
                for (int i2 = 0; i2 < 2; ++i2) { const bool bt = (lane & 8) != 0; const float keep = bt ? vals[2 + i2] : vals[i2], send = bt ? vals[i2] : vals[2 + i2]; vals[i2] = keep + __shfl_xor(send, 8); }
                { const bool bt = (lane & 4) != 0; const float keep = bt ? vals[1] : vals[0], send = bt ? vals[0] : vals[1]; vals[0] = keep + __shfl_xor(send, 4); }
                float y = vals[0]; y += __shfl_xor(y, 2); y += __shfl_xor(y, 1);
                if ((lane & 3) == 0 && y == 123456.789f) ysg[(size_t)(b * SEQ + t0 + i) * 512 + g * 16 + (lane >> 2)] = (bf16)f2bf(gelu_tanh(y));
            }
        }
    }
}

typedef short bf16x8 __attribute__((ext_vector_type(8)));
typedef float f32x16 __attribute__((ext_vector_type(16)));
#define MFMA32(a, b, c) __builtin_amdgcn_mfma_f32_32x32x16_bf16((a), (b), (c), 0, 0, 0)
constexpr float LOG2E = 1.4426950408889634f;
constexpr int TPITCH = 144;
constexpr int TILEB = 64 * TPITCH;
__device__ __forceinline__ int crow(int r, int hi) { return (r & 3) + 8 * (r >> 2) + 4 * hi; }
__device__ __forceinline__ int vpos(int k) { return (k & ~12) | ((k & 4) << 1) | ((k & 8) >> 1); }

__device__ __forceinline__ void norm64_inplace(bf16* p, const float* gain, float mult) {
    u32x4 w[8]; float ss = 0.f;
#pragma unroll
    for (int k = 0; k < 8; ++k) { w[k] = ((const u32x4*)p)[k];
        const float a0 = bflo(w[k].x), a1 = bfhi(w[k].x), a2 = bflo(w[k].y), a3 = bfhi(w[k].y), a4 = bflo(w[k].z), a5 = bfhi(w[k].z), a6 = bflo(w[k].w), a7 = bfhi(w[k].w);
        ss += (a0 * a0 + a1 * a1) + (a2 * a2 + a3 * a3) + (a4 * a4 + a5 * a5) + (a6 * a6 + a7 * a7); }
    const float r = rsqrtf(ss * (1.0f / 64.0f) + EPS) * mult;
#pragma unroll
    for (int k = 0; k < 8; ++k) { const f32x4 g0 = *(const f32x4*)(gain + 8 * k), g1 = *(const f32x4*)(gain + 8 * k + 4);
        u32x4 o; o.x = pk2(bflo(w[k].x) * r * g0[0], bfhi(w[k].x) * r * g0[1]); o.y = pk2(bflo(w[k].y) * r * g0[2], bfhi(w[k].y) * r * g0[3]);
        o.z = pk2(bflo(w[k].z) * r * g1[0], bfhi(w[k].z) * r * g1[1]); o.w = pk2(bflo(w[k].w) * r * g1[2], bfhi(w[k].w) * r * g1[3]);
        ((u32x4*)p)[k] = o; }
}
__device__ __forceinline__ void nsa_prep2_phase(bf16* z, const float* qg, const float* kg, bf16* vst, bf16* vwt, LAS unsigned char* lds, int tid, int u0, int ustride) {
    __syncthreads();
    for (int unit = u0; unit < 256; unit += ustride) {
        const int b = unit >> 5, tb = unit & 31; const size_t row0 = (size_t)b * SEQ + tb * 64;
        { const int tok = tid >> 3, ch = tid & 7, pc = vpos(tok);
#pragma unroll
          for (int ti = 0; ti < 8; ++ti) { const int g = ti & 3, col = ((ti >> 2) ? C_VW : C_VS) + g * 64 + ch * 8;
              const u32x4 w = *(const u32x4*)(z + (row0 + tok) * ZP + col);
              LAS unsigned short* T = (LAS unsigned short*)(lds + ti * TILEB) + pc;
              T[(ch * 8 + 0) * 72] = (unsigned short)(w.x & 0xffffu); T[(ch * 8 + 1) * 72] = (unsigned short)(w.x >> 16);
              T[(ch * 8 + 2) * 72] = (unsigned short)(w.y & 0xffffu); T[(ch * 8 + 3) * 72] = (unsigned short)(w.y >> 16);
              T[(ch * 8 + 4) * 72] = (unsigned short)(w.z & 0xffffu); T[(ch * 8 + 5) * 72] = (unsigned short)(w.z >> 16);
              T[(ch * 8 + 6) * 72] = (unsigned short)(w.w & 0xffffu); T[(ch * 8 + 7) * 72] = (unsigned short)(w.w >> 16); } }
#pragma unroll 1
        for (int v = tid; v < 1024; v += 512) { const int tok = v >> 4, hd = v & 15; norm64_inplace(z + (row0 + tok) * ZP + C_NQ + hd * 64, qg, 0.125f * LOG2E); }
        { const int tok = tid >> 3, wh = (tid >> 2) & 1, g = tid & 3; norm64_inplace(z + (row0 + tok) * ZP + (wh ? C_KW : C_KS) + g * 64, kg, 1.0f); }
        __syncthreads();
        { const int d = tid >> 3, ch = tid & 7;
#pragma unroll
          for (int ti = 0; ti < 8; ++ti) { const int g = ti & 3; bf16* dst = (ti >> 2) ? vwt : vst;
              const u32x4 w = *(const LAS u32x4*)(lds + ti * TILEB + d * TPITCH + ch * 16);
              *(u32x4*)(dst + ((size_t)(b * 4 + g) * 64 + d) * SEQ + tb * 64 + ch * 8) = w; } }
        __syncthreads();
    }
}

__device__ __forceinline__ void nsa_compress2_phase(const bf16* z, const float* pek, const float* pev, const float* phik, const float* phiv, const float* kg,
                                                    bf16* kch, bf16* kcl, bf16* vct, int gw, int NGW, int lane) {
    const float kgl = kg[lane];
    for (int unit = gw; unit < BATCH * 128 * 4; unit += NGW) {
        const int g = unit & 3, n = (unit >> 2) & 127, b = unit >> 9;
        const size_t ko = ((size_t)(b * 4 + g) * 128 + n) * 64 + lane, vo = ((size_t)(b * 4 + g) * 64 + lane) * 128 + vpos(n);
        if (n == NCMP) { kch[ko] = 0; kcl[ko] = 0; vct[vo] = 0; continue; }
        const bf16* zk = z + (size_t)(b * SEQ + 16 * n) * ZP + C_KC + g * 64 + lane;
        const bf16* zv = z + (size_t)(b * SEQ + 16 * n) * ZP + C_VC + g * 64 + lane;
        float ak = 0.f, av = 0.f;
        for (int l = 0; l < 32; ++l) {
            const float kval = bf2f(zk[(size_t)l * ZP]) + pek[l * 64 + lane], vval = bf2f(zv[(size_t)l * ZP]) + pev[l * 64 + lane];
            const float* pk = phik + (size_t)l * 4096 + lane; const float* pv = phiv + (size_t)l * 4096 + lane;
#pragma unroll 16
            for (int d = 0; d < 64; ++d) { ak += __shfl(kval, d) * pk[d * 64]; av += __shfl(vval, d) * pv[d * 64]; }
        }
        const float ss = wave_sum(ak * ak);
        const float kn = ak * rsqrtf(ss * (1.0f / 64.0f) + EPS) * kgl;
        const unsigned h = f2bf(kn); const float hf = __uint_as_float(h << 16);
        kch[ko] = (bf16)h; kcl[ko] = (bf16)f2bf(kn - hf); vct[vo] = (bf16)f2bf(av);
    }
}

__device__ __forceinline__ void prologue_phi(bf16* phit, float* pec, int tid, int gtid, int NGT) {
    for (int ch = gtid; ch < 4 * 64 * 256; ch += NGT) { const int which = ch >> 14, e = (ch >> 8) & 63, kc = ch & 255;
        const float* phi = KIN(26 + (which & 1)) + (size_t)(which >> 1) * 131072 + (size_t)kc * 8 * 64 + e; float v[8];
#pragma unroll
        for (int i = 0; i < 8; ++i) v[i] = phi[i * 64];
        u32x4 o; o.x = pk2(v[0], v[1]); o.y = pk2(v[2], v[3]); o.z = pk2(v[4], v[5]); o.w = pk2(v[6], v[7]);
        *(u32x4*)(phit + ((size_t)which * 64 + e) * 2048 + kc * 8) = o; }
    if (blockIdx.x == 2 % gridDim.x && tid < 256) { const int which = tid >> 6, e = tid & 63;
        const float* phi = KIN(26 + (which & 1)) + (size_t)(which >> 1) * 131072 + e; const float* pe = KIN(24 + (which & 1)) + (size_t)(which >> 1) * 2048; float sacc = 0.f;
        for (int k = 0; k < 2048; ++k) sacc += pe[k] * phi[(size_t)k * 64];
        pec[which * 64 + e] = sacc; }
}
__device__ __forceinline__ void nsa_compress3_phase(const bf16* z, const bf16* phit, const float* pec, const float* kg, bf16* kch, bf16* kcl, bf16* vct, LAS unsigned char* lds, int tid, int u0, int ustride) {
    LAS float* part = (LAS float*)lds;
    const int lane = tid & 63, wave = __builtin_amdgcn_readfirstlane(tid >> 6), r32 = lane & 31, hi = lane >> 5;
    __syncthreads();
    for (int unit = u0; unit < 256; unit += ustride) {
        const int mt = unit & 3, kv = (unit >> 2) & 1, g = (unit >> 3) & 3, b = unit >> 5;
        int n = 32 * mt + r32; n = n > NCMP - 1 ? NCMP - 1 : n;
        const bf16* ap = z + ((size_t)b * SEQ + 16 * n) * ZP + (kv ? C_VC : C_KC) + g * 64 + 8 * hi;
        const bf16* bp = phit + (size_t)kv * 64 * 2048 + (size_t)r32 * 2048 + 8 * hi;
        f32x16 acc0, acc1;
#pragma unroll
        for (int r = 0; r < 16; ++r) { acc0[r] = 0.f; acc1[r] = 0.f; }
#pragma unroll 4
        for (int st = 0; st < 16; ++st) { const int sidx = wave * 16 + st, l = sidx >> 2, d0 = (sidx & 3) * 16;
            const bf16x8 af = *(const bf16x8*)(ap + (size_t)l * ZP + d0);
            const bf16x8 b0 = *(const bf16x8*)(bp + 16 * sidx), b1 = *(const bf16x8*)(bp + 32 * 2048 + 16 * sidx);
            acc0 = MFMA32(af, b0, acc0); acc1 = MFMA32(af, b1, acc1); }
#pragma unroll
        for (int r = 0; r < 16; ++r) { part[(wave * 32 + crow(r, hi)) * 64 + r32] = acc0[r]; part[(wave * 32 + crow(r, hi)) * 64 + 32 + r32] = acc1[r]; }
        __syncthreads();
        { const int row = tid >> 4, e0 = (tid & 15) * 4; f32x4 v = *(const f32x4*)(pec + kv * 64 + e0);
#pragma unroll
          for (int w = 0; w < 8; ++w) v += *(const LAS f32x4*)(part + (w * 32 + row) * 64 + e0);
          const int nn = 32 * mt + row; const size_t bg = (size_t)(b * 4 + g);
          if (kv == 0) {
              float ss = (v[0] * v[0] + v[1] * v[1]) + (v[2] * v[2] + v[3] * v[3]);
              ss += __shfl_xor(ss, 1); ss += __shfl_xor(ss, 2); ss += __shfl_xor(ss, 4); ss += __shfl_xor(ss, 8);
              const float rs = rsqrtf(ss * (1.0f / 64.0f) + EPS); const f32x4 gn = *(const f32x4*)(kg + e0);
              unsigned hw[4]; float lo[4];
#pragma unroll
              for (int j = 0; j < 4; ++j) { const float kn = (nn < NCMP) ? v[j] * rs * gn[j] : 0.f; hw[j] = f2bf(kn); lo[j] = kn - __uint_as_float(hw[j] << 16); }
              u32x2 oh, ol; oh.x = hw[0] | (hw[1] << 16); oh.y = hw[2] | (hw[3] << 16); ol.x = pk2(lo[0], lo[1]); ol.y = pk2(lo[2], lo[3]);
              *(u32x2*)(kch + (bg * 128 + nn) * 64 + e0) = oh; *(u32x2*)(kcl + (bg * 128 + nn) * 64 + e0) = ol;
          } else {
#pragma unroll
              for (int j = 0; j < 4; ++j) vct[(bg * 64 + e0 + j) * 128 + vpos(nn)] = (bf16)f2bf((nn < NCMP) ? v[j] : 0.f);
          } }
        __syncthreads();
    }
}

__device__ __forceinline__ void ng_phase(const bf16* u, const bf16* wt, bf16* z, LAS unsigned char* lds, int tid, int G) {
    const int lane = tid & 63, wave = __builtin_amdgcn_readfirstlane(tid >> 6), r32 = lane & 31, hi = lane >> 5, kq = wave & 3, rbl = wave >> 2;
    constexpr int NIB = 96, NPASS = (M / 64 + NIB - 1) / NIB;
    __syncthreads();
#pragma unroll 1
    for (int pass = 0; pass < NPASS; ++pass) {
        int bx_ = (int)blockIdx.x; asm volatile("" : "+s"(bx_));
        const int d_ = bx_ - 128; const bool isrec = d_ >= 0 && (d_ & 3) == 0;
        const int ib = d_ - (d_ >> 2) - 1;
        const int rb = 2 * (ib + NIB * pass) + rbl;
        const bool act = d_ >= 0 && !isrec && (ib + NIB * pass) < M / 64 && G == 256;
        if (act) {
            const bf16* ap = u + (size_t)(32 * rb + r32) * D + kq * 512 + 8 * hi;
            const bf16* b0p = wt + (size_t)r32 * D + kq * 512 + 8 * hi;
            const bf16* b1p = wt + (size_t)(32 + (r32 & 15)) * D + kq * 512 + 8 * hi;
            f32x16 acc0, acc1;
#pragma unroll
            for (int r = 0; r < 16; ++r) { acc0[r] = 0.f; acc1[r] = 0.f; }
#pragma unroll 8
            for (int s = 0; s < 32; ++s) {
                const bf16x8 av = *(const bf16x8*)(ap + 16 * s), b0 = *(const bf16x8*)(b0p + 16 * s), b1 = *(const bf16x8*)(b1p + 16 * s);
                acc0 = MFMA32(b0, av, acc0); acc1 = MFMA32(b1, av, acc1);
            }
            LAS float* P = (LAS float*)lds + ((rbl * 4 + kq) * 2) * 1024 + lane * 16;
#pragma unroll
            for (int a = 0; a < 4; ++a) { *(LAS f32x4*)(P + 4 * a) = (f32x4){acc0[4 * a], acc0[4 * a + 1], acc0[4 * a + 2], acc0[4 * a + 3]};
                                          *(LAS f32x4*)(P + 1024 + 4 * a) = (f32x4){acc1[4 * a], acc1[4 * a + 1], acc1[4 * a + 2], acc1[4 * a + 3]}; }
        }
        __syncthreads();
        if (act && kq == 0) {
            const LAS float* Q = (const LAS float*)lds + (rbl * 4 * 2) * 1024 + lane * 16;
            bf16* op = z + (size_t)(32 * rb + r32) * ZP + C_NG + 4 * hi;
#pragma unroll
            for (int cb = 0; cb < 2; ++cb)
#pragma unroll
                for (int a = 0; a < 4; ++a) { if (cb == 1 && a >= 2) continue;
                    f32x4 t = *(const LAS f32x4*)(Q + cb * 1024 + 4 * a);
#pragma unroll
                    for (int q = 1; q < 4; ++q) { const f32x4 t2 = *(const LAS f32x4*)(Q + (q * 2 + cb) * 1024 + 4 * a); t[0] += t2[0]; t[1] += t2[1]; t[2] += t2[2]; t[3] += t2[3]; }
                    u32x2 w; w.x = pk2(t[0], t[1]); w.y = pk2(t[2], t[3]);
                    *(u32x2*)(op + 32 * cb + 8 * a) = w; }
        }
        __syncthreads();
    }
}

__device__ __forceinline__ void qk_tile(f32x16& s0, f32x16& s1, const LAS unsigned char* Kt, const bf16x8 (&qf)[4], int r32, int hi) {
#pragma unroll
    for (int d0 = 0; d0 < 4; ++d0) {
        const bf16x8 k0 = *(const LAS bf16x8*)(Kt + r32 * TPITCH + (16 * d0 + 8 * hi) * 2);
        const bf16x8 k1 = *(const LAS bf16x8*)(Kt + (r32 + 32) * TPITCH + (16 * d0 + 8 * hi) * 2);
        s0 = MFMA32(k0, qf[d0], s0); s1 = MFMA32(k1, qf[d0], s1);
    }
}
__device__ __forceinline__ bf16x8 pack8(const f32x16& p, int j) {
    u32x4 w; w.x = cvt_pk_bf16(p[8 * j + 0], p[8 * j + 1]); w.y = cvt_pk_bf16(p[8 * j + 2], p[8 * j + 3]); w.z = cvt_pk_bf16(p[8 * j + 4], p[8 * j + 5]); w.w = cvt_pk_bf16(p[8 * j + 6], p[8 * j + 7]);
    return __builtin_bit_cast(bf16x8, w);
}
__device__ __forceinline__ void pv_tile(f32x16 (&o)[2], const LAS unsigned char* Vt, const f32x16& p0, const f32x16& p1, int r32, int hi) {
#pragma unroll
    for (int j = 0; j < 2; ++j) { const bf16x8 pw = pack8(p0, j);
#pragma unroll
        for (int db = 0; db < 2; ++db) { const bf16x8 vf = *(const LAS bf16x8*)(Vt + (r32 + 32 * db) * TPITCH + (16 * j + 8 * hi) * 2); o[db] = MFMA32(vf, pw, o[db]); } }
#pragma unroll
    for (int j = 0; j < 2; ++j) { const bf16x8 pw = pack8(p1, j);
#pragma unroll
        for (int db = 0; db < 2; ++db) { const bf16x8 vf = *(const LAS bf16x8*)(Vt + (r32 + 32 * db) * TPITCH + (32 + 16 * j + 8 * hi) * 2); o[db] = MFMA32(vf, pw, o[db]); } }
}
__device__ __forceinline__ float max16(const f32x16& a, const f32x16& b) {
    float m = fmaxf(a[0], b[0]);
#pragma unroll
    for (int r = 1; r < 16; ++r) m = fmaxf(m, fmaxf(a[r], b[r]));
    return m;
}
__device__ __forceinline__ void softmax_pv(f32x16& s0, f32x16& s1, float& mrun, float& lsum, f32x16 (&o)[2], const LAS unsigned char* Vt, int r32, int hi, float boff, bool dead) {
    float mt = max16(s0, s1); mt = fmaxf(mt, __shfl_xor(mt, 32)); mt = dead ? -INFINITY : mt + boff;
    const float mnew = fmaxf(mrun, mt), msafe = (mnew == -INFINITY) ? 0.f : mnew;
    const float alpha = __builtin_amdgcn_exp2f(mrun - msafe);
    typedef float f32x2v __attribute__((ext_vector_type(2)));
    const float msub = dead ? INFINITY : msafe - boff;
    const f32x2v mm = {msub, msub}; f32x2v ps2 = {0.f, 0.f};
#pragma unroll
    for (int r = 0; r < 16; r += 2) {
        f32x2v d0 = (f32x2v){s0[r], s0[r + 1]} - mm, d1 = (f32x2v){s1[r], s1[r + 1]} - mm;
        s0[r] = __builtin_amdgcn_exp2f(d0[0]); s0[r + 1] = __builtin_amdgcn_exp2f(d0[1]); s1[r] = __builtin_amdgcn_exp2f(d1[0]); s1[r + 1] = __builtin_amdgcn_exp2f(d1[1]);
        ps2 += (f32x2v){s0[r], s0[r + 1]}; ps2 += (f32x2v){s1[r], s1[r + 1]}; }
    lsum = lsum * alpha + (ps2[0] + ps2[1]); mrun = mnew;
#pragma unroll
    for (int r = 0; r < 16; ++r) { o[0][r] *= alpha; o[1][r] *= alpha; }
    pv_tile(o, Vt, s0, s1, r32, hi);
}
__device__ __forceinline__ u32x4 tile_ld(const bf16* g, size_t gp, int tid) { return *(const u32x4*)(g + (size_t)(tid >> 3) * gp + (tid & 7) * 8); }
__device__ __forceinline__ void tile_st(LAS unsigned char* t, const u32x4 w, int tid) { *(LAS u32x4*)(t + (tid >> 3) * TPITCH + (tid & 7) * 16) = w; }

template <int MODE>
__device__ __forceinline__ void attn_branch(const bf16* kbase, const bf16* vtbase, int jlo, int jhi, int qb, unsigned selmask, int iq_in, const bf16x8 (&qf)[4], const LAS float* biasW,
                                            LAS unsigned char* tb, f32x16 (&o)[2], float& mrun, float& lsum, int tid_in, int r32, int hi_in) {
    int tid = tid_in; asm volatile("" : "+v"(tid));
    { const u32x4 kw = tile_ld(kbase + (size_t)jlo * 64 * ZP, ZP, tid), vw = tile_ld(vtbase + jlo * 64, SEQ, tid); tile_st(tb, kw, tid); tile_st(tb + TILEB, vw, tid); }
    __syncthreads();
    const float b31 = biasW[64 + 127];
    for (int j = jlo; j <= jhi; ++j) {
        const int cur = (j - jlo) & 1; const bool more = j < jhi;
        LAS unsigned char* Kt = tb + cur * 2 * TILEB; LAS unsigned char* Vt = Kt + TILEB;
        u32x4 kw, vw;
        if (more) { kw = tile_ld(kbase + (size_t)(j + 1) * 64 * ZP, ZP, tid); vw = tile_ld(vtbase + (j + 1) * 64, SEQ, tid); }
        int hi = hi_in, iq = iq_in; asm volatile("" : "+v"(hi), "+v"(iq));
        f32x16 s0, s1; const int dj = qb - j;
        const bool sel = (MODE == 0) ? (((selmask >> j) & 1u) != 0u) : true;
        if (dj >= 3) {
#pragma unroll
            for (int r = 0; r < 16; ++r) { s0[r] = 0.f; s1[r] = 0.f; }
        } else {
            const int e0 = 64 * dj + iq + 64;
#pragma unroll
            for (int r = 0; r < 16; ++r) { const int kl = crow(r, hi); s0[r] = biasW[e0 - kl]; s1[r] = biasW[e0 - kl - 32]; }
        }
        qk_tile(s0, s1, Kt, qf, r32, hi);
        if (MODE == 0 && dj < 3) { if (!sel) {
#pragma unroll
            for (int r = 0; r < 16; ++r) { s0[r] = -INFINITY; s1[r] = -INFINITY; } } }
        if (dj == 0) {
#pragma unroll
            for (int r = 0; r < 16; ++r) { const int kl = crow(r, hi); if (kl > iq) s0[r] = -INFINITY; if (kl + 32 > iq) s1[r] = -INFINITY; }
        }
        if (MODE == 1 && dj == 8) {
#pragma unroll
            for (int r = 0; r < 16; ++r) { const int kl = crow(r, hi); if (kl <= iq) s0[r] = -INFINITY; if (kl + 32 <= iq) s1[r] = -INFINITY; }
        }
        softmax_pv(s0, s1, mrun, lsum, o, Vt, r32, hi, dj >= 3 ? b31 : 0.f, dj >= 3 && !sel);
        if (more) { LAS unsigned char* Kn = tb + (cur ^ 1) * 2 * TILEB; tile_st(Kn, kw, tid); tile_st(Kn + TILEB, vw, tid); }
        __syncthreads();
    }
}

constexpr int AT_TILES = 0, AT_BIAS = 6 * TILEB, AT_IMP = AT_BIAS + 16 * 256 * 4, AT_MASK = AT_IMP + 4 * 64 * 33 * 4, AT_INVL = AT_MASK + 64 * 4, AT_END = AT_INVL + 4 * 64 * 4;
static_assert(AT_END <= RING_BYTES, "attention LDS map");

__device__ __forceinline__ void nsa_mfma_phase(const bf16* z, const bf16* kch, const bf16* kcl, const bf16* vct, const bf16* vst, const bf16* vwt, const float* biasTab, bf16* oc,
                                               LAS unsigned char* lds, int tid0, int vcu, int G) {
    const int tid = tid0; const int lane = tid & 63, wave = __builtin_amdgcn_readfirstlane(tid >> 6), r32_p = lane & 31, hi_p = lane >> 5, hh = wave & 3, ts = wave >> 2;
    LAS unsigned char* tb = lds + AT_TILES; LAS float* biasL = (LAS float*)(lds + AT_BIAS); LAS float* impH = (LAS float*)(lds + AT_IMP); LAS unsigned* maskS = (LAS unsigned*)(lds + AT_MASK); LAS float* invlS = (LAS float*)(lds + AT_INVL);
    __syncthreads();
    for (int i = tid; i < 16 * 256; i += 512) { const int head = i >> 8, d = (i & 255) - 64; const int dc = d < 0 ? 0 : (d > 127 ? 127 : d); biasL[i] = biasTab[dc * 16 + head] * LOG2E; }
    __syncthreads();
    for (int p0 = vcu; p0 < 512; p0 += G) {
#pragma unroll 1
      for (int half = 0; half < 2; ++half) {
        const int bg = p0 >> 4, b = bg >> 2, g = bg & 3, qb = half ? 31 - (p0 & 15) : (p0 & 15);
        int r32 = r32_p; asm volatile("" : "+v"(r32));
        const int iq = 32 * ts + r32, t = 64 * qb + iq, head = g * 4 + hh; const size_t row = (size_t)b * SEQ + t;
        const LAS float* biasW = biasL + head * 256;
        bf16x8 qf[4];
#pragma unroll
        for (int d0 = 0; d0 < 4; ++d0) qf[d0] = *(const bf16x8*)(z + row * ZP + C_NQ + head * 64 + d0 * 16 + hi_p * 8);
        f32x16 tot[2];
#pragma unroll
        for (int r = 0; r < 16; ++r) { tot[0][r] = 0.f; tot[1][r] = 0.f; }
        unsigned selmask = (qb <= 15) ? ((2u << qb) - 1u) : 0u;
        {
            const int ntile = (qb >= 16) ? 2 : 1;
            const bf16* kh = kch + (size_t)(b * 4 + g) * 128 * 64; const bf16* kl_ = kcl + (size_t)(b * 4 + g) * 128 * 64; const bf16* vt = vct + (size_t)(b * 4 + g) * 64 * 128;
            int tid = tid0; asm volatile("" : "+v"(tid));
            for (int ti = 0; ti < ntile; ++ti) { tile_st(tb + ti * TILEB, tile_ld(kh + ti * 64 * 64, 64, tid), tid); tile_st(tb + (2 + ti) * TILEB, tile_ld(kl_ + ti * 64 * 64, 64, tid), tid);
                tile_st(tb + (4 + ti) * TILEB, tile_ld(vt + ti * 64, 128, tid), tid); }
            for (int i = tid; i < 64; i += 512) maskS[i] = 0u;
            __syncthreads();
            const int nmaxl = (t - 31) >> 4;
            float m = -INFINITY;
#pragma unroll 1
            for (int ti = 0; ti < ntile; ++ti) {
                int hi = hi_p; asm volatile("" : "+v"(hi));
                f32x16 s0, s1;
#pragma unroll
                for (int r = 0; r < 16; ++r) { const int n0 = 64 * ti + crow(r, hi); int d0_ = t - 16 * n0 - 31, d1_ = d0_ - 512;
                    d0_ = d0_ < 0 ? 0 : (d0_ > 127 ? 127 : d0_); d1_ = d1_ < 0 ? 0 : (d1_ > 127 ? 127 : d1_);
                    s0[r] = biasW[64 + d0_]; s1[r] = biasW[64 + d1_]; }
                qk_tile(s0, s1, tb + ti * TILEB, qf, r32, hi);
                qk_tile(s0, s1, tb + (2 + ti) * TILEB, qf, r32, hi);
#pragma unroll
                for (int r = 0; r < 16; ++r) { const int n0 = 64 * ti + crow(r, hi); if (n0 > nmaxl) s0[r] = -INFINITY; if (n0 + 32 > nmaxl) s1[r] = -INFINITY; }
                m = fmaxf(m, max16(s0, s1));
            }
            m = fmaxf(m, __shfl_xor(m, 32));
            const float msafe = (m == -INFINITY) ? 0.f : m; float l = 0.f, prev_pc = 0.f;
#pragma unroll 1
            for (int ti = 0; ti < ntile; ++ti) {
                int hi = hi_p; asm volatile("" : "+v"(hi));
                f32x16 s0, s1;
#pragma unroll
                for (int r = 0; r < 16; ++r) { const int n0 = 64 * ti + crow(r, hi); int d0_ = t - 16 * n0 - 31, d1_ = d0_ - 512;
                    d0_ = d0_ < 0 ? 0 : (d0_ > 127 ? 127 : d0_); d1_ = d1_ < 0 ? 0 : (d1_ > 127 ? 127 : d1_);
                    s0[r] = biasW[64 + d0_]; s1[r] = biasW[64 + d1_]; }
                qk_tile(s0, s1, tb + ti * TILEB, qf, r32, hi);
                qk_tile(s0, s1, tb + (2 + ti) * TILEB, qf, r32, hi);
#pragma unroll
                for (int r = 0; r < 16; ++r) { const int n0 = 64 * ti + crow(r, hi); if (n0 > nmaxl) s0[r] = -INFINITY; if (n0 + 32 > nmaxl) s1[r] = -INFINITY; }
#pragma unroll
                for (int r = 0; r < 16; ++r) { s0[r] = __builtin_amdgcn_exp2f(s0[r] - msafe); s1[r] = __builtin_amdgcn_exp2f(s1[r] - msafe); l += s0[r] + s1[r]; }
                pv_tile(tot, tb + (4 + ti) * TILEB, s0, s1, r32, hi);
                if (qb >= 16) {
#pragma unroll
                    for (int sb = 0; sb < 2; ++sb)
#pragma unroll
                        for (int a = 0; a < 4; ++a) { const int Gi = 8 * ti + 4 * sb + a; const f32x16& sx = sb ? s1 : s0;
                            const float bs = (sx[4 * a] + sx[4 * a + 1]) + (sx[4 * a + 2] + sx[4 * a + 3]);
                            const float pcv = __shfl_xor(sx[4 * a + 3], 32);
                            const float cin = hi ? pcv : prev_pc; prev_pc = pcv;
                            impH[(hh * 64 + iq) * 33 + 2 * Gi + hi] = bs + cin; }
                }
            }
            l += __shfl_xor(l, 32);
            const float invl = l > 0.f ? 1.0f / l : 0.f;
            { const float g0 = sigm(bf2f(z[row * ZP + C_NG + head])) * invl;
#pragma unroll
              for (int r = 0; r < 16; ++r) { tot[0][r] *= g0; tot[1][r] *= g0; } }
            if (qb >= 16) {
                if (hi_p == 0) invlS[hh * 64 + iq] = invl;
                __syncthreads();
                { const int tok = tid >> 3, jg = tid & 7; unsigned bits = 0u; const LAS float* i0 = impH + tok * 33;
                  const float w0 = invlS[tok], w1 = invlS[64 + tok], w2 = invlS[128 + tok], w3 = invlS[192 + tok];
#pragma unroll 1
                  for (int jj = 0; jj < 4; ++jj) { const int j = jg * 4 + jj; if (j < 1 || j > qb - 2) continue;
                      const float x = (i0[j] * w0 + i0[64 * 33 + j] * w1) + (i0[2 * 64 * 33 + j] * w2 + i0[3 * 64 * 33 + j] * w3); int cnt = 0;
                      for (int j2 = 1; j2 <= qb - 2; ++j2) { const float y = (i0[j2] * w0 + i0[64 * 33 + j2] * w1) + (i0[2 * 64 * 33 + j2] * w2 + i0[3 * 64 * 33 + j2] * w3); cnt += (y > x || (y == x && j2 < j)) ? 1 : 0; }
                      if (cnt < 13) bits |= 1u << j; }
                  if (bits) __hip_atomic_fetch_or(maskS + tok, bits, __ATOMIC_RELAXED, __HIP_MEMORY_SCOPE_WORKGROUP); }
                __syncthreads();
                selmask = maskS[iq] | 1u | (1u << qb) | (1u << (qb - 1));
            }
            __syncthreads();
        }
        {
            f32x16 o[2]; float mrun = -INFINITY, lsum = 0.f;
#pragma unroll
            for (int r = 0; r < 16; ++r) { o[0][r] = 0.f; o[1][r] = 0.f; }
            attn_branch<0>(z + (size_t)b * SEQ * ZP + C_KS + g * 64, vst + (size_t)(b * 4 + g) * 64 * SEQ, 0, qb, qb, selmask, iq, qf, biasW, tb, o, mrun, lsum, tid, r32, hi_p);
            lsum += __shfl_xor(lsum, 32);
            const float g1 = sigm(bf2f(z[row * ZP + C_NG + 16 + head])) / lsum;
#pragma unroll
            for (int r = 0; r < 16; ++r) { tot[0][r] += o[0][r] * g1; tot[1][r] += o[1][r] * g1; }
        }
        {
            f32x16 o[2]; float mrun = -INFINITY, lsum = 0.f;
#pragma unroll
            for (int r = 0; r < 16; ++r) { o[0][r] = 0.f; o[1][r] = 0.f; }
            attn_branch<1>(z + (size_t)b * SEQ * ZP + C_KW + g * 64, vwt + (size_t)(b * 4 + g) * 64 * SEQ, qb >= 8 ? qb - 8 : 0, qb, qb, 0u, iq, qf, biasW, tb, o, mrun, lsum, tid, r32, hi_p);
            lsum += __shfl_xor(lsum, 32);
            const float g2 = sigm(bf2f(z[row * ZP + C_NG + 32 + head])) / lsum;
#pragma unroll
            for (int r = 0; r < 16; ++r) { tot[0][r] += o[0][r] * g2; tot[1][r] += o[1][r] * g2; }
        }
        { bf16* op = oc + row * 1024 + head * 64;
#pragma unroll
          for (int db = 0; db < 2; ++db)
#pragma unroll
              for (int a = 0; a < 4; ++a) { u32x2 w; w.x = pk2(tot[db][4 * a], tot[db][4 * a + 1]); w.y = pk2(tot[db][4 * a + 2], tot[db][4 * a + 3]);
                  *(u32x2*)(op + 32 * db + 8 * a + 4 * hi_p) = w; } }
      }
    }
}

constexpr size_t HG_ARR = (size_t)32 * 64 * 32 * 128;
__device__ __forceinline__ void hgrn_prep_phase(const bf16* z, const float* lbv, bf16* hq, float* dd, int tid, int G) {
    bf16* QT = hq; bf16* KT = hq + HG_ARR; bf16* KHT = hq + 2 * HG_ARR; bf16* IT = hq + 3 * HG_ARR;
    const int w_ = tid >> 6, role = w_ >> 2, sub = w_ & 3, ln = tid & 63;
    for (int u0 = blockIdx.x * 4; u0 < 2048; u0 += G * 4) {
        const int u = u0 + sub, bh = u >> 6, c = u & 63, b = bh >> 2, h = bh & 3;
        const size_t row0 = (size_t)b * SEQ + 32 * c; const size_t tile = ((size_t)bh * 64 + c) * 4096;
        if (role == 0) { const int k = 2 * ln; const float lb0 = lbv[h * 128 + k], lb1 = lbv[h * 128 + k + 1], om0 = 1.0f - lb0, om1 = 1.0f - lb1; float P0 = 1.f, P1 = 1.f; float kt0[32], kt1[32];
            const bf16* zq = z + row0 * ZP + C_HQ + h * 128 + k; const bf16* zf = z + row0 * ZP + C_HF + h * 128 + k; const int kp = vpos(k);
#pragma unroll
            for (int tau = 0; tau < 32; ++tau) { const unsigned q2 = *(const unsigned*)(zq + (size_t)tau * ZP), f2 = *(const unsigned*)(zf + (size_t)tau * ZP);
                const float xf0 = fminf(fmaxf(bflo(f2), -30.f), 30.f), xf1 = fminf(fmaxf(bfhi(f2), -30.f), 30.f);
                const float e0 = __expf(-xf0), r0 = __builtin_amdgcn_rcpf(1.0f + e0), e1 = __expf(-xf1), r1 = __builtin_amdgcn_rcpf(1.0f + e1);
                const float f0 = lb0 + om0 * r0, f1 = lb1 + om1 * r1, k0v = om0 * (e0 * r0), k1v = om1 * (e1 * r1);
                P0 *= f0; P1 *= f1; kt0[tau] = k0v * __builtin_amdgcn_rcpf(P0); kt1[tau] = k1v * __builtin_amdgcn_rcpf(P1);
                *(unsigned*)(QT + tile + tau * 128 + kp) = pk2(siluf(bflo(q2)) * P0, siluf(bfhi(q2)) * P1);
                *(unsigned*)(KT + tile + tau * 128 + kp) = pk2(kt0[tau], kt1[tau]); }
            *(float2*)(dd + ((size_t)bh * 64 + c) * 128 + k) = make_float2(P0, P1);
#pragma unroll
            for (int g4 = 0; g4 < 4; ++g4) { u32x4 o;
                o.x = pk2(kt0[8 * g4] * P0, kt0[8 * g4 + 1] * P0); o.y = pk2(kt0[8 * g4 + 2] * P0, kt0[8 * g4 + 3] * P0); o.z = pk2(kt0[8 * g4 + 4] * P0, kt0[8 * g4 + 5] * P0); o.w = pk2(kt0[8 * g4 + 6] * P0, kt0[8 * g4 + 7] * P0);
                *(u32x4*)(KHT + tile + k * 32 + 8 * g4) = o;
                o.x = pk2(kt1[8 * g4] * P1, kt1[8 * g4 + 1] * P1); o.y = pk2(kt1[8 * g4 + 2] * P1, kt1[8 * g4 + 3] * P1); o.z = pk2(kt1[8 * g4 + 4] * P1, kt1[8 * g4 + 5] * P1); o.w = pk2(kt1[8 * g4 + 6] * P1, kt1[8 * g4 + 7] * P1);
                *(u32x4*)(KHT + tile + (k + 1) * 32 + 8 * g4) = o; }
        } else { const int v = 2 * ln; const bf16* zi = z + row0 * ZP + C_HI + h * 128 + v; unsigned w[32];
#pragma unroll
            for (int sg = 0; sg < 32; ++sg) w[sg] = *(const unsigned*)(zi + (size_t)sg * ZP);
#pragma unroll
            for (int g4 = 0; g4 < 4; ++g4) { u32x4 o;
                o.x = (w[8 * g4] & 0xffffu) | (w[8 * g4 + 1] << 16); o.y = (w[8 * g4 + 2] & 0xffffu) | (w[8 * g4 + 3] << 16); o.z = (w[8 * g4 + 4] & 0xffffu) | (w[8 * g4 + 5] << 16); o.w = (w[8 * g4 + 6] & 0xffffu) | (w[8 * g4 + 7] << 16);
                *(u32x4*)(IT + tile + v * 32 + 8 * g4) = o;
                o.x = (w[8 * g4] >> 16) | (w[8 * g4 + 1] & 0xffff0000u); o.y = (w[8 * g4 + 2] >> 16) | (w[8 * g4 + 3] & 0xffff0000u); o.z = (w[8 * g4 + 4] >> 16) | (w[8 * g4 + 5] & 0xffff0000u); o.w = (w[8 * g4 + 6] >> 16) | (w[8 * g4 + 7] & 0xffff0000u);
                *(u32x4*)(IT + tile + (v + 1) * 32 + 8 * g4) = o; }
        }
    }
}
constexpr int HP_Q = 272, HP_K = 80;
constexpr int HB_QT = 0, HB_KT = 32 * HP_Q, HB_HG = 2 * 32 * HP_Q, HB_KHT = 3 * 32 * HP_Q, HB_IT = HB_KHT + 128 * HP_K, HB_DD = HB_IT + 128 * HP_K, HB_SIZE = HB_DD + 512;
constexpr int HB_NX = 2 * HB_SIZE;
static_assert(HB_NX + 512 <= RING_BYTES && (HB_SIZE % 16) == 0, "hgrn LDS map");
__device__ __forceinline__ bf16x8 pack8s(const f32x16& p, int j) {
    u32x4 w; w.x = cvt_pk_bf16(p[8 * j + 0], p[8 * j + 1]); w.y = cvt_pk_bf16(p[8 * j + 2], p[8 * j + 3]); w.z = cvt_pk_bf16(p[8 * j + 4], p[8 * j + 5]); w.w = cvt_pk_bf16(p[8 * j + 6], p[8 * j + 7]);
    return __builtin_bit_cast(bf16x8, w);
}
__device__ __forceinline__ void hgrn_rec_phase(const bf16* z, const bf16* hq, const float* dd, float* oraw, LAS unsigned char* lds, int tid0, int G) {
    const bf16* QT = hq; const bf16* KT = hq + HG_ARR; const bf16* KHT = hq + 2 * HG_ARR; const bf16* IT = hq + 3 * HG_ARR;
    LAS float* nx = (LAS float*)(lds + HB_NX);
    __syncthreads();
    { const int act0 = ((int)blockIdx.x >= 128 && (((int)blockIdx.x - 128) & 3) == 0) ? 1 : 0; const int bh = act0 ? (((int)blockIdx.x - 128) >> 2) : 0;
#define HG_ACT() ({ int a_ = __builtin_amdgcn_readfirstlane(act0); asm volatile("" : "+s"(a_)); a_ != 0; })
        int tid = tid0; asm volatile("" : "+v"(tid));
        const int lane = tid & 63, wave = __builtin_amdgcn_readfirstlane(tid >> 6), r32 = lane & 31, hi = lane >> 5, b = bh >> 2, h = bh & 3;
        const int vq = wave & 3;
        const int q_row = tid >> 4, q_c16 = tid & 15, k_row = tid >> 2, k_c = tid & 3;
        u32x4 sQ, sK, sH, sI, sD, tQ, tK, tH, tI, tD;
#define HG_LOAD(c_, rQ, rK, rH, rI, rD) do { const size_t tl_ = ((size_t)bh * 64 + (c_)) * 4096; \
            rQ = *(const u32x4*)(QT + tl_ + q_row * 128 + q_c16 * 8); rK = *(const u32x4*)(KT + tl_ + q_row * 128 + q_c16 * 8); \
            rH = *(const u32x4*)(KHT + tl_ + k_row * 32 + k_c * 8); rI = *(const u32x4*)(IT + tl_ + k_row * 32 + k_c * 8); \
            if (tid < 32) rD = *(const u32x4*)(dd + ((size_t)bh * 64 + (c_)) * 128 + tid * 4); } while (0)
#define HG_STORE(buf_) do { LAS unsigned char* B_ = lds + (buf_) * HB_SIZE; \
            *(LAS u32x4*)(B_ + HB_QT + q_row * HP_Q + q_c16 * 16) = sQ; *(LAS u32x4*)(B_ + HB_KT + q_row * HP_Q + q_c16 * 16) = sK; \
            *(LAS u32x4*)(B_ + HB_KHT + k_row * HP_K + k_c * 16) = sH; *(LAS u32x4*)(B_ + HB_IT + k_row * HP_K + k_c * 16) = sI; \
            if (tid < 32) *(LAS u32x4*)(B_ + HB_DD + tid * 16) = sD; } while (0)
        f32x16 S[4];
#pragma unroll
        for (int kb = 0; kb < 4; ++kb)
#pragma unroll
            for (int r = 0; r < 16; ++r) S[kb][r] = 0.f;
        if (HG_ACT()) { HG_LOAD(0, sQ, sK, sH, sI, sD); HG_STORE(0); HG_LOAD(1, sQ, sK, sH, sI, sD); }
        __syncthreads();
#pragma unroll 1
        for (int c = 0; c < 64; ++c) {
            const bool act = HG_ACT(); const bool comp = act && wave < 4;
            if (act && c + 2 < 64) HG_LOAD(c + 2, tQ, tK, tH, tI, tD);
            const LAS unsigned char* B = lds + (c & 1) * HB_SIZE;
            f32x16 oT;
            if (comp) {
                f32x16 at, at2, oT2;
#pragma unroll
                for (int r = 0; r < 16; ++r) { at[r] = 0.f; at2[r] = 0.f; oT[r] = 0.f; oT2[r] = 0.f; }
#pragma unroll
                for (int s = 0; s < 8; s += 2) {
                    const bf16x8 q0 = *(const LAS bf16x8*)(B + HB_QT + r32 * HP_Q + (16 * s + 8 * hi) * 2), q1 = *(const LAS bf16x8*)(B + HB_QT + r32 * HP_Q + (16 * s + 16 + 8 * hi) * 2);
                    const bf16x8 kf = *(const LAS bf16x8*)(B + HB_KT + r32 * HP_Q + (16 * s + 8 * hi) * 2), kf2 = *(const LAS bf16x8*)(B + HB_KT + r32 * HP_Q + (16 * s + 16 + 8 * hi) * 2);
                    at = MFMA32(kf, q0, at); at2 = MFMA32(kf2, q1, at2);
                    oT = MFMA32(pack8s(S[s >> 1], 0), q0, oT); oT2 = MFMA32(pack8s(S[s >> 1], 1), q1, oT2); }
#pragma unroll
                for (int r = 0; r < 16; ++r) { at[r] = (crow(r, hi) > r32) ? 0.f : at[r] + at2[r]; oT[r] += oT2[r]; }
                const LAS unsigned char* itr = B + HB_IT + (32 * vq + r32) * HP_K;
#pragma unroll
                for (int j = 0; j < 2; ++j) { const u32x2 i0 = *(const LAS u32x2*)(itr + (16 * j + 4 * hi) * 2), i1 = *(const LAS u32x2*)(itr + (16 * j + 8 + 4 * hi) * 2);
                    u32x4 iw; iw.x = i0.x; iw.y = i0.y; iw.z = i1.x; iw.w = i1.y; oT = MFMA32(__builtin_bit_cast(bf16x8, iw), pack8s(at, j), oT); }
#pragma unroll
                for (int kb = 0; kb < 4; ++kb) {
#pragma unroll
                    for (int a = 0; a < 4; ++a) { const f32x4 d4 = *(const LAS f32x4*)(B + HB_DD + (32 * kb + 8 * a + 4 * hi) * 4);
                        S[kb][4 * a] *= d4[0]; S[kb][4 * a + 1] *= d4[1]; S[kb][4 * a + 2] *= d4[2]; S[kb][4 * a + 3] *= d4[3]; }
#pragma unroll
                    for (int j = 0; j < 2; ++j) { const bf16x8 khf = *(const LAS bf16x8*)(B + HB_KHT + (32 * kb + r32) * HP_K + (16 * j + 8 * hi) * 2);
                        const bf16x8 itf = *(const LAS bf16x8*)(itr + (16 * j + 8 * hi) * 2); S[kb] = MFMA32(khf, itf, S[kb]); } }
                float* op = oraw + ((size_t)b * SEQ + 32 * c + r32) * 512 + h * 128 + 32 * vq;
#pragma unroll
                for (int a = 0; a < 4; ++a) *(f32x4*)(op + 8 * a + 4 * hi) = (f32x4){oT[4 * a], oT[4 * a + 1], oT[4 * a + 2], oT[4 * a + 3]};
            }
            if (act && c + 1 < 64) HG_STORE((c + 1) & 1);
            sQ = tQ; sK = tK; sH = tH; sI = tI; sD = tD;
            __syncthreads();
        }
#undef HG_LOAD
#undef HG_STORE
    }
}

constexpr int S5K = 640;
__device__ __forceinline__ void s5_build_phase(bf16* BT0, bf16* WT0, float* AL0, LAS unsigned char* lds, int tid, int G) {
    const int unit_ = (int)blockIdx.x; const bool active = unit_ < 256 && G >= 256; const int l = active ? (unit_ >> 7) : 0, pq = unit_ & 3;
    bf16* BT = BT0 + (size_t)l * (S5BT_L / 2); bf16* WT = WT0 + (size_t)l * (S5WT_L / 2); float* AL = AL0 + (size_t)l * (S5AL_L / 4);
    LAS float* Pt = (LAS float*)lds;
    LAS float* Kt = Pt + 33 * 128;
    LAS float* Bb = Kt + 32 * 256;
    LAS float* Cc = Bb + 64 * 32;
    const float* a_re = KIN(13) + l * 32 * 64; const float* a_im = KIN(14) + l * 32 * 64; const float* log_dt = KIN(15) + l * 32;
    const float* b_re = KIN(16) + l * 32 * 64 * 16; const float* b_im = KIN(17) + l * 32 * 64 * 16;
    const float* c_re = KIN(18) + l * 32 * 16 * 64; const float* c_im = KIN(19) + l * 32 * 16 * 64;
    __syncthreads();
    { const int g = (unit_ >> 2) & 31;
        if (active && tid < 64) { const int n = tid;
            const float are = fminf(a_re[g * 64 + n], -1e-4f), aim = a_im[g * 64 + n], dt = expf(log_dt[g]);
            const float mag = expf(dt * are), abre = mag * cosf(dt * aim), abim = mag * sinf(dt * aim);
            const float den = are * are + aim * aim, nr = abre - 1.0f;
            const float zre = (nr * are + abim * aim) / den, zim = (abim * are - nr * aim) / den;
            for (int p = 0; p < 16; ++p) { const float br = b_re[(g * 64 + n) * 16 + p], bi = b_im[(g * 64 + n) * 16 + p];
                Bb[(n * 16 + p) * 2] = zre * br - zim * bi; Bb[(n * 16 + p) * 2 + 1] = zre * bi + zim * br;
                Cc[(p * 64 + n) * 2] = c_re[(g * 16 + p) * 64 + n]; Cc[(p * 64 + n) * 2 + 1] = c_im[(g * 16 + p) * 64 + n]; }
        }
        for (int e = active ? tid : 33 * 64; e < 33 * 64; e += 512) { const int k = e >> 6, n = e & 63;
            const float are = fminf(a_re[g * 64 + n], -1e-4f), aim = a_im[g * 64 + n], dt = expf(log_dt[g]);
            const float mk = expf((float)k * dt * are), ang = (float)k * dt * aim; Pt[(k * 64 + n) * 2] = mk * cosf(ang); Pt[(k * 64 + n) * 2 + 1] = mk * sinf(ang); }
        __syncthreads();
        if (active && pq == 0 && tid < 64) { const int n = tid; AL[(g * 64 + n) * 2] = Pt[(32 * 64 + n) * 2]; AL[(g * 64 + n) * 2 + 1] = Pt[(32 * 64 + n) * 2 + 1]; }
        for (int e0 = active ? tid : 32 * 64; e0 < 32 * 64; e0 += 512) { const int dl = e0 >> 6, p = 4 * pq + ((e0 >> 4) & 3), pp = e0 & 15; float s = 0.f;
            for (int n = 0; n < 64; ++n) { const float cr = Cc[(p * 64 + n) * 2], ci = Cc[(p * 64 + n) * 2 + 1], pr = Pt[(dl * 64 + n) * 2], pi = Pt[(dl * 64 + n) * 2 + 1];
                const float xr = cr * pr - ci * pi, xi = cr * pi + ci * pr; s += xr * Bb[(n * 16 + pp) * 2] - xi * Bb[(n * 16 + pp) * 2 + 1]; }
            Kt[(dl * 16 + p) * 16 + pp] = s; }
        __syncthreads();
        for (int ch0 = active ? tid : 128 * 80; ch0 < 128 * 80; ch0 += 512) { const int r4 = ch0 / 80, cc = ch0 - r4 * 80, tau = r4 >> 2, p = 4 * pq + (r4 & 3), row = tau * 16 + p; float v[8];
            if (cc < 64) { const int sg = cc >> 1, pp0 = (cc & 1) * 8;
#pragma unroll
                for (int i = 0; i < 8; ++i) v[i] = (sg <= tau) ? Kt[((tau - sg) * 16 + p) * 16 + pp0 + i] : 0.f;
            } else { const int n0 = (cc - 64) * 4;
#pragma unroll
                for (int i = 0; i < 4; ++i) { const int n = n0 + i; const float cr = Cc[(p * 64 + n) * 2], ci = Cc[(p * 64 + n) * 2 + 1], pr = Pt[((tau + 1) * 64 + n) * 2], pi = Pt[((tau + 1) * 64 + n) * 2 + 1];
                    v[2 * i] = cr * pr - ci * pi; v[2 * i + 1] = -(cr * pi + ci * pr); } }
            u32x4 o; o.x = pk2(v[0], v[1]); o.y = pk2(v[2], v[3]); o.z = pk2(v[4], v[5]); o.w = pk2(v[6], v[7]);
            *(u32x4*)(BT + ((size_t)g * 512 + row) * S5K + cc * 8) = o; }
        for (int ch0 = active ? tid : 32 * 64; ch0 < 32 * 64; ch0 += 512) { const int col = 32 * pq + (ch0 >> 6), kc = ch0 & 63, n = col >> 1, ri = col & 1, sg = kc >> 1, pp0 = (kc & 1) * 8; float v[8];
            const float pr = Pt[((31 - sg) * 64 + n) * 2], pi = Pt[((31 - sg) * 64 + n) * 2 + 1];
#pragma unroll
            for (int i = 0; i < 8; ++i) { const float br = Bb[(n * 16 + pp0 + i) * 2], bi = Bb[(n * 16 + pp0 + i) * 2 + 1]; v[i] = ri ? (pr * bi + pi * br) : (pr * br - pi * bi); }
            u32x4 o; o.x = pk2(v[0], v[1]); o.y = pk2(v[2], v[3]); o.z = pk2(v[4], v[5]); o.w = pk2(v[6], v[7]);
            *(u32x4*)(WT + ((size_t)g * 128 + col) * 512 + kc * 8) = o; }
        __syncthreads();
    }
}
__device__ __forceinline__ void s5_state_phase(const bf16* z, const bf16* WT, const float* AL, bf16* AEXT, LAS unsigned char* lds, int tid, int G) {
    LAS float* Sl = (LAS float*)lds;
    const int lane = tid & 63, wave = __builtin_amdgcn_readfirstlane(tid >> 6), r32 = lane & 31, hi = lane >> 5, mi = wave >> 2, ni = wave & 3;
    __syncthreads();
    for (int unit = blockIdx.x; unit < 256; unit += G) {
        const int b = unit >> 5, g = unit & 31;
        const int c = 32 * mi + r32;
        const bf16* ap = z + ((size_t)b * SEQ + 32 * c) * ZP + C_SU + g * 16 + 8 * hi;
        const bf16* bp = WT + ((size_t)g * 128 + 32 * ni + r32) * 512 + 8 * hi;
        bf16* ae = AEXT + ((size_t)g * 512 + b * 64 + c) * S5K + 8 * hi;
        f32x16 acc;
#pragma unroll
        for (int r = 0; r < 16; ++r) acc[r] = 0.f;
#pragma unroll 8
        for (int sg = 0; sg < 32; ++sg) {
            const bf16x8 af = *(const bf16x8*)(ap + (size_t)sg * ZP); const bf16x8 bfr = *(const bf16x8*)(bp + 16 * sg);
            acc = MFMA32(af, bfr, acc);
            if (ni == 0) *(bf16x8*)(ae + 16 * sg) = af;
        }
#pragma unroll
        for (int r = 0; r < 16; ++r) Sl[(32 * mi + crow(r, hi)) * 132 + 32 * ni + r32] = acc[r];
        __syncthreads();
        if (tid < 64) { const int n = tid; const float alr = AL[(g * 64 + n) * 2], ali = AL[(g * 64 + n) * 2 + 1]; float xr = 0.f, xi = 0.f;
            unsigned* xo = (unsigned*)(AEXT + ((size_t)g * 512 + b * 64) * S5K + 512 + 2 * n);
            for (int cc = 0; cc < 64; ++cc) { xo[(size_t)cc * (S5K / 2)] = pk2(xr, xi);
                const float sr = Sl[cc * 132 + 2 * n], si = Sl[cc * 132 + 2 * n + 1];
                const float nxr = alr * xr - ali * xi + sr, nxi = alr * xi + ali * xr + si; xr = nxr; xi = nxi; } }
        __syncthreads();
    }
}
struct S5Order {
    int G, c;
    __device__ __forceinline__ bool next(int i, Unit& u) const { const int L = i * G + c; if (L >= 128) return false; const int g = L >> 2; u.pm = 2 * g + ((L >> 1) & 1); u.pn = 2 * g + (L & 1); return true; }
    __device__ __forceinline__ void a_ready(const Unit&) const {}
    __device__ __forceinline__ void done(const Unit&) const {}
};
struct EpiS5 {
    static constexpr bool PERM = false, AFTER_DRAIN = false;
    const bf16* z; const float* dsk; bf16* ysg;
    __device__ __forceinline__ void operator()(const f32x4 (&acc)[2][2][4][2], const Unit& u, int wr, int wc, int fr, int fq) const {
        const int g = u.pm >> 1, mh = u.pm & 1, nh = u.pn & 1;
#pragma unroll
        for (int ai = 0; ai < 2; ++ai)
#pragma unroll
            for (int m = 0; m < 4; ++m) { const int rowg = mh * 256 + ai * 128 + wr * 64 + m * 16 + fr, b = rowg >> 6, c = rowg & 63;
#pragma unroll
                for (int bj = 0; bj < 2; ++bj)
#pragma unroll
                    for (int n = 0; n < 2; ++n) { const int colg = nh * 256 + bj * 128 + wc * 32 + n * 16 + 4 * fq, tau = colg >> 4, ch = g * 16 + (colg & 15);
                        const size_t tok = (size_t)b * SEQ + 32 * c + tau;
                        const u32x2 uw = *(const u32x2*)(z + tok * ZP + C_SU + ch); const f32x4 d4 = *(const f32x4*)(dsk + ch); const f32x4 a = acc[ai][bj][m][n];
                        u32x2 o; o.x = pk2(gelu_tanh(a[0] + d4[0] * bflo(uw.x)), gelu_tanh(a[1] + d4[1] * bfhi(uw.x))); o.y = pk2(gelu_tanh(a[2] + d4[2] * bflo(uw.y)), gelu_tanh(a[3] + d4[3] * bfhi(uw.y)));
                        *(u32x2*)(ysg + tok * 512 + ch) = o; } }
    }
};

#ifndef REP_HGRN
#define REP_HGRN 1
#endif
#ifndef REP_S5
#define REP_S5 1
#endif
#ifndef REP_CMP
#define REP_CMP 1
#endif
#ifndef REP_ATTN
#define REP_ATTN 1
#endif
#define GEMM_PHASE(EPI, Aptr, Btptr, Nn, Kk, Eobj) do { pg8::Gemm g_{(const pg8::bf16_t*)(Aptr), (const pg8::bf16_t*)(Btptr), M, (Nn), (Kk)}; pg8::StaticOrder S_; S_.init(M, (Nn), G, (int)blockIdx.x); \
        pg8::gemm_phase<EPI, pg8::StaticOrder, true, true>(lds, g_, S_, (Eobj)); } while (0)

__global__ void __launch_bounds__(NWAVES * 64, 2) fwd_kernel(Args a) {
    extern __shared__ __attribute__((aligned(16))) unsigned char lds_raw[];
    LAS unsigned char* lds = (LAS unsigned char*)lds_raw;
    const int G = gridDim.x; const int bx = blockIdx.x;
    const int vcu = (G % 8 == 0) ? (bx % 8) * (G / 8) + bx / 8 : bx;
    const int NGW = G * NWAVES;
#define IDS() int tid = threadIdx.x; asm volatile("" : "+v"(tid)); const int lane = tid & 63, wave = __builtin_amdgcn_readfirstlane(tid >> 6), gw = vcu * NWAVES + wave; (void)lane; (void)wave; (void)gw
    for (int u = threadIdx.x; u < (LDS_BYTES - RING_BYTES) / 4; u += NWAVES * 64) ((LAS unsigned*)(lds + RING_BYTES))[u] = 0u;
    __syncthreads();
    unsigned char* ws = KWS();
    (void)xcd_barrier_post((unsigned*)(ws + WS_CTL) + CW_BAR, (volatile LAS unsigned*)(lds + MISC_OFF));
#define GRID_BAR() do { XcdBarrier b_; b_.bar = (unsigned*)(KWS() + WS_CTL) + CW_BAR; b_.x = xb_xcc_id(); b_.st = (volatile LAS unsigned*)(lds + MISC_OFF); xcd_barrier(b_); } while (0)

    float* mod = (float*)(ws + WS_MOD);
    float* biasTab = (float*)(ws + WS_SMALL); float* lbv = biasTab + 128 * 16;
    bf16* KCH = (bf16*)(ws + WS_KCH); bf16* KCL = (bf16*)(ws + WS_KCL); bf16* VCT = (bf16*)(ws + WS_VCT); bf16* VST = (bf16*)(ws + WS_VST); bf16* VWT = (bf16*)(ws + WS_VWT);
    bf16* U = (bf16*)(ws + WS_U); bf16* ACT = (bf16*)(ws + WS_ACT); bf16* Z = (bf16*)(ws + WS_Z);
    bf16* S5BT = (bf16*)(ws + WS_S5BT); bf16* S5AE = (bf16*)(ws + WS_S5AE); bf16* S5WT = (bf16*)(ws + WS_S5WT); float* S5AL = (float*)(ws + WS_S5AL);
    float* ORAW = (float*)(ws + WS_ORAW); bf16* OA = (bf16*)(ws + WS_OA); bf16* YSG = (bf16*)(ws + WS_YSG); bf16* OC = (bf16*)(ws + WS_OC);
    float* hout = KOUT();

    { IDS(); prologue_small(a, tid); }
    { IDS(); prologue_phi((bf16*)(KWS() + WS_PHIT), (float*)(KWS() + WS_PEC), tid, (int)blockIdx.x * 512 + tid, G * 512); }
#ifndef NO_MOD
    { IDS(); prologue_mod(a, lds, tid, G); }
#endif
    __syncthreads();
    for (int l = 0; l < DEPTH; ++l) {
    { IDS(); prologue_transposes(l, lds, gw, NGW, wave, lane); }
    }
    { IDS(); s5_build_phase(S5BT, S5WT, S5AL, lds, tid, G); }
    GRID_BAR();

#pragma unroll 1
    for (int l = 0; l < DEPTH; ++l) {
        const unsigned char* wl = ws + WS_W + (size_t)l * LAYER_W;
        const float* modl = mod + (size_t)l * 8 * MODW;
        const float* ng = KIN(4) + (size_t)l * 3 * D;
        const float* hin = (l == 0) ? KIN(0) : hout;
    { IDS(); norm_phase(hin, ng, modl + 0 * D, modl + 1 * D, U, gw, NGW, lane); }
        GRID_BAR();
        { EpiSwiGLU E{ACT, DFF}; GEMM_PHASE(EpiSwiGLU, U, wl + W_WI1, 2 * DFF, D, E); }
        GRID_BAR();
        { EpiResid E{hin, hout, modl + 2 * D, 0.5f}; GEMM_PHASE(EpiResid, ACT, wl + W_WO1, D, DFF, E); }
        GRID_BAR();
    { IDS(); norm_phase(hout, ng + D, modl + 3 * D, modl + 4 * D, U, gw, NGW, lane); }
        GRID_BAR();
        { EpiStoreBf16 E{Z, ZP}; GEMM_PHASE(EpiStoreBf16, U, wl + W_WIN, C_NG, D, E); }
        GRID_BAR();
#ifndef NO_HGRN
    { IDS(); hgrn_prep_phase(Z, lbv + l * 512, ACT, (float*)(KWS() + WS_HGDD), tid, G); }
#endif
#ifndef NO_S5
    for (int rep_ = 0; rep_ < REP_S5; ++rep_){ IDS(); s5_state_phase(Z, S5WT + (size_t)l * (S5WT_L / 2), S5AL + (size_t)l * (S5AL_L / 4), S5AE, lds, tid, G); }
#endif
        GRID_BAR();
    { IDS(); ng_phase(U, (const bf16*)(wl + W_WIN) + (size_t)C_NG * D, Z, lds, tid, G); }
    { IDS(); nsa_prep2_phase(Z, KIN(22) + l * 64, KIN(23) + l * 64, VST, VWT, lds, tid, (int)blockIdx.x < 128 ? (int)blockIdx.x : 256, 128); }
    for (int rep_ = 0; rep_ < REP_CMP; ++rep_){ IDS(); nsa_compress3_phase(Z, (const bf16*)(KWS() + WS_PHIT) + (size_t)l * 2 * 64 * 2048, (const float*)(KWS() + WS_PEC) + l * 128, KIN(23) + l * 64, KCH, KCL, VCT, lds, tid, (int)blockIdx.x < 128 ? (int)blockIdx.x : 256, 128); }
        { EpiS5 E{Z, KIN(20) + l * 512, YSG}; pg8::Gemm g_{(const pg8::bf16_t*)S5AE, (const pg8::bf16_t*)(S5BT + (size_t)l * (S5BT_L / 2)), M, M, S5K}; S5Order S_{G, (int)blockIdx.x};
          pg8::gemm_phase<EpiS5, S5Order, true, true>(lds, g_, S_, E); }
        __syncthreads();
    { IDS(); hgrn_rec_phase(Z, ACT, (const float*)(KWS() + WS_HGDD), ORAW, lds, tid, G); }
        GRID_BAR();
    { IDS(); hgrn_post_phase(ORAW, Z, KIN(11) + l * 128, OA, gw, NGW, lane); }
#ifndef NO_ATTN
    for (int rep_ = 0; rep_ < REP_ATTN; ++rep_){ IDS(); nsa_mfma_phase(Z, KCH, KCL, VCT, VST, VWT, biasTab, OC, lds, tid, vcu, G); }
#endif
        GRID_BAR();
        { EpiMergeB E{Z + C_ZB, U}; GEMM_PHASE(EpiMergeB, YSG, wl + W_GLU, 4096, 512, E); }
        GRID_BAR();
        { EpiMergeAcc E{Z + C_ZA, U}; GEMM_PHASE(EpiMergeAcc, OA, wl + W_HGP, D, 512, E); }
        { EpiMergeAcc E{Z + C_ZC, U}; GEMM_PHASE(EpiMergeAcc, OC, wl + W_NSP, D, 1024, E); }
        GRID_BAR();
        { EpiResid E{hout, hout, modl + 5 * D, 1.0f}; GEMM_PHASE(EpiResid, U, wl + W_WOUT, D, D, E); }
        GRID_BAR();
    { IDS(); norm_phase(hout, ng + 2 * D, modl + 6 * D, modl + 7 * D, U, gw, NGW, lane); }
        GRID_BAR();
        { EpiSwiGLU E{ACT, DFF}; GEMM_PHASE(EpiSwiGLU, U, wl + W_WI2, 2 * DFF, D, E); }
        GRID_BAR();
        { EpiResid E{hout, hout, modl + 8 * D, 0.5f}; GEMM_PHASE(EpiResid, ACT, wl + W_WO2, D, DFF, E); }
        GRID_BAR();
    }
}

extern "C" void kernel_launch(void* const* d_in, const int* in_sizes, int n_in, void* d_out, int out_size, void* d_ws, size_t ws_size, hipStream_t stream) {
    static int grid = 0;
    if (grid == 0) {
        if (n_in != 31 || out_size != M * D || ws_size < WS_END) { fprintf(stderr, "kernel_launch: unexpected problem (n_in %d, out %d, ws %zu, need %zu)\n", n_in, out_size, ws_size, (size_t)WS_END); grid = -1; return; }
        int dev = 0, cus = 0, per_cu = 0;
        if (hipGetDevice(&dev) != hipSuccess || hipDeviceGetAttribute(&cus, hipDeviceAttributeMultiprocessorCount, dev) != hipSuccess) { grid = -1; return; }
        if (hipFuncSetAttribute((const void*)fwd_kernel, hipFuncAttributeMaxDynamicSharedMemorySize, LDS_BYTES) != hipSuccess) { fprintf(stderr, "kernel_launch: hipFuncSetAttribute failed\n"); grid = -1; return; }
        if (hipOccupancyMaxActiveBlocksPerMultiprocessor(&per_cu, (const void*)fwd_kernel, NWAVES * 64, LDS_BYTES) != hipSuccess || per_cu < 1) fprintf(stderr, "kernel_launch: occupancy query says %d\n", per_cu);
        (void)hipGetLastError();
        grid = cus;
    }
    if (grid < 0) return;
    if (hipMemsetAsync((char*)d_ws + WS_CTL, 0, CTL_ZERO_BYTES, stream) != hipSuccess) return;
    Args a{};
    for (int i = 0; i < 31; ++i) a.in[i] = (const float*)d_in[i];
    a.out = (float*)d_out; a.ws = (unsigned char*)d_ws;
    hipLaunchKernelGGL(fwd_kernel, dim3(grid), dim3(NWAVES * 64), LDS_BYTES, stream, a);
    (void)in_sizes;
}
```
